# Optimizing an MI355X kernel written in HIP

```python
import math
import jax, jax.numpy as jnp
from jax import lax
import numpy as np

D_MODEL = 1024
BATCH = 32
SEQ = 2048
DEPTH = 1
DEC_BATCH = 1
DEC_SEQ = 16384
PAST_LEN = 128

HY_WIDTH = 512
N_ATTN_HEADS = 8
HEAD_DIM = 64
ATTN_WIDTH = N_ATTN_HEADS * HEAD_DIM
MIX_WIDTH = HY_WIDTH + ATTN_WIDTH
HY_ORDER = 2
HY_DIRS = 2
HY_EMB = 33
HY_BANDS = (HY_EMB - 1) // 2
HY_FILTER_HIDDEN = 64
HY_DECAY_SLOW = 3.07
HY_DECAY_FAST = 15.35
DILATED_BRANCHES = ((128, 1), (512, 4), (2048, 16))
ATTN_BLOCK = 64
D_FF = 2816
NORM_EPS = 1e-6
NEG_INF = -1e30

kernel_name = 'hybrid_hyena_dilated_alibi_encoder'


def rmsnorm(x, g):
    xf = x.astype(jnp.float32)
    y = xf * lax.rsqrt(jnp.mean(xf * xf, axis=-1, keepdims=True) + NORM_EPS)
    return (y * g.astype(jnp.float32)).astype(x.dtype)


def dwconv3(x, w, b):
    xp = jnp.pad(x, ((0, 0), (1, 1), (0, 0)))
    return xp[:, :-2] * w[0] + xp[:, 1:-1] * w[1] + xp[:, 2:] * w[2] + b


def hyena_filters(L, w1, b1, sin_freq, w2, b2, w3, decay):
    f32 = jnp.float32
    t = jnp.arange(L, dtype=f32)
    tn = t / max(L - 1, 1)
    bands = jnp.linspace(1e-4, HY_BANDS - 1, HY_BANDS, dtype=f32)
    ang = (2.0 * math.pi / L) * t[:, None] * bands[None, :]
    feat = jnp.concatenate([tn[:, None], jnp.cos(ang), jnp.sin(ang)], axis=-1)
    sf = sin_freq.astype(f32)
    h = jnp.sin(sf[0] * (feat @ w1.astype(f32) + b1.astype(f32)))
    h = jnp.sin(sf[1] * (h @ w2.astype(f32) + b2.astype(f32)))
    h = (h @ w3.astype(f32)).reshape(L, HY_ORDER, HY_DIRS, HY_WIDTH)
    h = h * jnp.exp(-tn[:, None, None, None] * jnp.abs(decay.astype(f32))[None])
    h = h / jnp.sum(jnp.abs(h), axis=(0, 2), keepdims=True)
    h_fwd = h[:, :, 0]
    h_bwd = h[:, :, 1]
    k = jnp.concatenate([h_fwd, jnp.zeros((1, HY_ORDER, HY_WIDTH), f32), h_bwd[1:][::-1]], axis=0)
    return jnp.fft.rfft(k, axis=0)


def long_conv(z, kf, skip):
    L = z.shape[1]
    zf = z.astype(jnp.float32)
    y = jnp.fft.irfft(jnp.fft.rfft(zf, n=2 * L, axis=1) * kf[None], n=2 * L, axis=1)[:, :L]
    return (y + skip.astype(jnp.float32) * zf).astype(z.dtype)


def hyena_mixer(u, short_w, short_b, w1, b1, sin_freq, w2, b2, w3, decay, skip):
    L = u.shape[1]
    u = dwconv3(u, short_w, short_b)
    v, x1, x2 = jnp.split(u, 3, axis=-1)
    kf = hyena_filters(L, w1, b1, sin_freq, w2, b2, w3, decay)
    z = x1 * long_conv(v, kf[:, 0], skip[0])
    z = x2 * long_conv(z, kf[:, 1], skip[1])
    return z


def alibi_slopes():
    return jnp.asarray(np.array([2.0 ** (-8.0 * (h + 1) / N_ATTN_HEADS) for h in range(N_ATTN_HEADS)], dtype=np.float32))


def dilated_branch(q, k, v, slopes, window, dilation):
    B, T, H, E = q.shape
    R = window // (2 * dilation)
    Ls = T // dilation
    b = math.gcd(ATTN_BLOCK, Ls)
    nblk = Ls // b
    W = b + 2 * R

    def by_residue(a):
        return a.reshape(B, Ls, dilation, H, E).transpose(0, 2, 1, 3, 4)

    qb = by_residue(q).reshape(B, dilation, nblk, b, H, E)
    pad = ((0, 0), (0, 0), (R, R), (0, 0), (0, 0))
    idx = jnp.arange(nblk)[:, None] * b + jnp.arange(W)[None, :]
    kb = jnp.take(jnp.pad(by_residue(k), pad), idx, axis=2)
    vb = jnp.take(jnp.pad(by_residue(v), pad), idx, axis=2)
    s = jnp.einsum('brnqhe,brnkhe->brnhqk', qb, kb).astype(jnp.float32) * (E ** -0.5)
    rel = jnp.arange(W)[None, :] - R - jnp.arange(b)[:, None]
    key_pos = idx - R
    valid = (jnp.abs(rel) <= R)[None] & ((key_pos >= 0) & (key_pos < Ls))[:, None, :]
    bias = -slopes[:, None, None] * (jnp.abs(rel) * dilation).astype(jnp.float32)[None]
    s = jnp.where(valid[None, None, :, None], s + bias[None, None, None], NEG_INF)
    m = jnp.max(s, axis=-1, keepdims=True)
    p = jnp.exp(s - m)
    den = jnp.sum(p, axis=-1)
    o = jnp.einsum('brnhqk,brnkhe->brnqhe', p, vb.astype(jnp.float32)) / jnp.swapaxes(den, -1, -2)[..., None]
    lse = jnp.swapaxes(m[..., 0] + jnp.log(den), -1, -2)
    o = o.reshape(B, dilation, Ls, H, E).transpose(0, 2, 1, 3, 4).reshape(B, T, H, E)
    lse = lse.reshape(B, dilation, Ls, H).transpose(0, 2, 1, 3).reshape(B, T, H)
    return o, lse


def dilated_attention(u):
    B, T, _ = u.shape
    q, k, v = [a.reshape(B, T, N_ATTN_HEADS, HEAD_DIM) for a in jnp.split(u, 3, axis=-1)]
    slopes = alibi_slopes()
    outs, lses = [], []
    for window, dilation in DILATED_BRANCHES:
        o, lse = dilated_branch(q, k, v, slopes, window, dilation)
        outs.append(o)
        lses.append(lse)
    wts = jax.nn.softmax(jnp.stack(lses, axis=0), axis=0)
    o = jnp.sum(wts[..., None] * jnp.stack(outs, axis=0), axis=0)
    return o.reshape(B, T, ATTN_WIDTH).astype(u.dtype)


def encoder_layer(x, c, ada_w, ada_b, norm1_g, w_in, hy_short_w, hy_short_b, hy_pos_w1, hy_pos_b1,
                  hy_sin_freq, hy_pos_w2, hy_pos_b2, hy_pos_w3, hy_decay, hy_skip, hy_out_g, attn_out_g,
                  w_out, norm2_g, ffn_w_gate, ffn_w_up, ffn_conv_w, ffn_conv_b, ffn_w_down):
    mod = jax.nn.silu(c) @ ada_w + ada_b
    sh1, sc1, g1, sh2, sc2, g2 = jnp.split(mod[:, None, :], 6, axis=-1)
    h = rmsnorm(x, norm1_g) * (1 + sc1) + sh1
    proj = h @ w_in
    hy = hyena_mixer(proj[..., :3 * HY_WIDTH], hy_short_w, hy_short_b, hy_pos_w1, hy_pos_b1, hy_sin_freq,
                     hy_pos_w2, hy_pos_b2, hy_pos_w3, hy_decay, hy_skip)
    at = dilated_attention(proj[..., 3 * HY_WIDTH:])
    mix = jnp.concatenate([rmsnorm(hy, hy_out_g), rmsnorm(at, attn_out_g)], axis=-1) @ w_out
    x = x + g1 * mix
    h = rmsnorm(x, norm2_g) * (1 + sc2) + sh2
    gate = dwconv3(h @ ffn_w_gate, ffn_conv_w, ffn_conv_b)
    x = x + g2 * ((jax.nn.gelu(gate) * (h @ ffn_w_up)) @ ffn_w_down)
    return x


def setup_inputs(seed: int = 0) -> dict:
    key = jax.random.key(seed)
    ks = jax.random.split(key, 32)
    f32 = jnp.float32

    def nrm(k, shape, scale):
        return jax.random.normal(k, shape, f32) * scale

    def gain(k, shape):
        return 1.0 + 0.05 * jax.random.normal(k, shape, f32)

    decay_base = jnp.linspace(HY_DECAY_SLOW, HY_DECAY_FAST, HY_WIDTH, dtype=f32)
    return {
        'x_prompt': nrm(ks[0], (BATCH, SEQ, D_MODEL), 1.0),
        'x_sample': nrm(ks[1], (DEC_BATCH, DEC_SEQ, D_MODEL), 1.0),
        'c_prompt': nrm(ks[2], (BATCH, D_MODEL), 1.0),
        'c_sample': nrm(ks[3], (DEC_BATCH, D_MODEL), 1.0),
        'ada_w': nrm(ks[4], (DEPTH, D_MODEL, 6 * D_MODEL), 0.5 * D_MODEL ** -0.5),
        'ada_b': nrm(ks[5], (DEPTH, 6 * D_MODEL), 0.01),
        'norm1_g': gain(ks[6], (DEPTH, D_MODEL)),
        'w_in': nrm(ks[7], (DEPTH, D_MODEL, 3 * HY_WIDTH + 3 * ATTN_WIDTH), D_MODEL ** -0.5),
        'hy_short_w': nrm(ks[8], (DEPTH, 3, 3 * HY_WIDTH), 3 ** -0.5),
        'hy_short_b': nrm(ks[9], (DEPTH, 3 * HY_WIDTH), 0.01),
        'hy_pos_w1': nrm(ks[10], (DEPTH, HY_EMB, HY_FILTER_HIDDEN), HY_EMB ** -0.5),
        'hy_pos_b1': nrm(ks[11], (DEPTH, HY_FILTER_HIDDEN), 0.02),
        'hy_sin_freq': gain(ks[12], (DEPTH, 2, HY_FILTER_HIDDEN)),
        'hy_pos_w2': nrm(ks[13], (DEPTH, HY_FILTER_HIDDEN, HY_FILTER_HIDDEN), HY_FILTER_HIDDEN ** -0.5),
        'hy_pos_b2': nrm(ks[14], (DEPTH, HY_FILTER_HIDDEN), 0.02),
        'hy_pos_w3': nrm(ks[15], (DEPTH, HY_FILTER_HIDDEN, HY_ORDER * HY_DIRS * HY_WIDTH), HY_FILTER_HIDDEN ** -0.5),
        'hy_decay': decay_base * (1.0 + 0.1 * jax.random.normal(ks[16], (DEPTH, HY_ORDER, HY_DIRS, HY_WIDTH), f32)),
        'hy_skip': nrm(ks[17], (DEPTH, HY_ORDER, HY_WIDTH), 0.5),
        'hy_out_g': gain(ks[18], (DEPTH, HY_WIDTH)),
        'attn_out_g': gain(ks[19], (DEPTH, ATTN_WIDTH)),
        'w_out': nrm(ks[20], (DEPTH, MIX_WIDTH, D_MODEL), MIX_WIDTH ** -0.5),
        'norm2_g': gain(ks[21], (DEPTH, D_MODEL)),
        'ffn_w_gate': nrm(ks[22], (DEPTH, D_MODEL, D_FF), D_MODEL ** -0.5),
        'ffn_w_up': nrm(ks[23], (DEPTH, D_MODEL, D_FF), D_MODEL ** -0.5),
        'ffn_conv_w': nrm(ks[24], (DEPTH, 3, D_FF), 3 ** -0.5),
        'ffn_conv_b': nrm(ks[25], (DEPTH, D_FF), 0.01),
        'ffn_w_down': nrm(ks[26], (DEPTH, D_FF, D_MODEL), D_FF ** -0.5),
        'final_g': gain(ks[27], (D_MODEL,)),
    }


def reference(x_prompt, x_sample, c_prompt, c_sample, ada_w, ada_b, norm1_g, w_in, hy_short_w, hy_short_b,
              hy_pos_w1, hy_pos_b1, hy_sin_freq, hy_pos_w2, hy_pos_b2, hy_pos_w3, hy_decay, hy_skip, hy_out_g,
              attn_out_g, w_out, norm2_g, ffn_w_gate, ffn_w_up, ffn_conv_w, ffn_conv_b, ffn_w_down, final_g):
    def trunk(x, c):
        for l in range(DEPTH):
            x = encoder_layer(x, c, ada_w[l], ada_b[l], norm1_g[l], w_in[l], hy_short_w[l], hy_short_b[l],
                              hy_pos_w1[l], hy_pos_b1[l], hy_sin_freq[l], hy_pos_w2[l], hy_pos_b2[l],
                              hy_pos_w3[l], hy_decay[l], hy_skip[l], hy_out_g[l], attn_out_g[l], w_out[l],
                              norm2_g[l], ffn_w_gate[l], ffn_w_up[l], ffn_conv_w[l], ffn_conv_b[l], ffn_w_down[l])
        return rmsnorm(x, final_g)

    y_prompt = trunk(x_prompt, c_prompt)
    y_sample = trunk(x_sample, c_sample)
    return (y_prompt, y_sample)
```

```cpp
#include <hip/hip_runtime.h>
#include <hip/hip_cooperative_groups.h>
#include <cstdio>
namespace cg = cooperative_groups;

#define LAS __attribute__((address_space(3)))
typedef unsigned short bf16_t;
typedef short bf16x8 __attribute__((ext_vector_type(8)));
typedef float f32x4 __attribute__((ext_vector_type(4)));
typedef unsigned u32x4 __attribute__((ext_vector_type(4)));
typedef unsigned u32x2 __attribute__((ext_vector_type(2)));
typedef float c2 __attribute__((ext_vector_type(2)));

constexpr int D = 1024, NTOK = 81920, NPTOK = 65536, TP = 2048, TS = 16384, NB = 33;
constexpr int NPROJ = 3072, HYW = 512, DFF = 2816, MODW = 6144;
constexpr int NTHR = 512;
constexpr float EPS = 1e-6f;
constexpr int LDS_BYTES = 139520 + 1024;

constexpr size_t MiB = 1048576;
constexpr size_t WS_NORM = 0;
constexpr size_t WS_BAR  = 16384;
constexpr size_t WS_MOD  = 65536;
constexpr size_t WS_WIN  = 2 * MiB;
constexpr size_t WS_WOUT = 8 * MiB;
constexpr size_t WS_WGU  = 10 * MiB;
constexpr size_t WS_WD   = 21 * MiB;
constexpr size_t WS_RC   = 27 * MiB;
constexpr size_t WS_RB   = WS_RC + 240 * MiB;
constexpr size_t WS_RD   = WS_RB + 240 * MiB;
constexpr size_t WS_RE   = WS_RD + 80 * MiB;
constexpr size_t WS_RG   = WS_RE + 80 * MiB;
constexpr size_t WS_RA   = WS_RG + 144 * MiB;
constexpr size_t WS_END  = WS_RA + 184 * MiB;
constexpr size_t WS_FILTS = WS_RG, WS_FILTP = WS_RG + 128 * MiB;
constexpr size_t WS_ATO2 = WS_RG, WS_LSE = WS_RG + 80 * MiB;
constexpr size_t ATO_STRIDE_01 = 80 * MiB;
constexpr size_t SCR_PER_BLOCK = (15 + 8) * 4096 * 8;

struct Params {
    const float *x_prompt, *x_sample, *c_prompt, *c_sample, *ada_w, *ada_b, *norm1_g, *w_in, *hy_short_w, *hy_short_b,
        *hy_pos_w1, *hy_pos_b1, *hy_sin_freq, *hy_pos_w2, *hy_pos_b2, *hy_pos_w3, *hy_decay, *hy_skip, *hy_out_g,
        *attn_out_g, *w_out, *norm2_g, *ffn_w_gate, *ffn_w_up, *ffn_conv_w, *ffn_conv_b, *ffn_w_down, *final_g;
    float* out; unsigned char* ws;
    int ph_lo, ph_hi;
};

typedef __bf16 bf16v2_t __attribute__((ext_vector_type(2)));
typedef float f32v2_t __attribute__((ext_vector_type(2)));
__device__ __forceinline__ unsigned cvtpk(float lo, float hi) { const f32v2_t v = {lo, hi}; const bf16v2_t b = __builtin_convertvector(v, bf16v2_t); return __builtin_bit_cast(unsigned, b); }
__device__ __forceinline__ unsigned pk2(float lo, float hi) { return cvtpk(lo, hi); }
__device__ __forceinline__ bf16_t f2bf(float f) { return (bf16_t)cvtpk(f, 0.f); }
__device__ __forceinline__ float bf2f(bf16_t b) { return __uint_as_float(((unsigned)b) << 16); }
__device__ __forceinline__ const float* xrow(const Params& p, int g) { return g < NPTOK ? p.x_prompt + (size_t)g * D : p.x_sample + (size_t)(g - NPTOK) * D; }
__device__ __forceinline__ int batch_of(int g) { return g < NPTOK ? (g >> 11) : 32; }
__device__ __forceinline__ int fresh_tid(int wave) {
    int l; asm volatile("v_mbcnt_lo_u32_b32 %0, -1, 0\n\tv_mbcnt_hi_u32_b32 %0, -1, %0" : "=v"(l));
    return (wave << 6) | l; }

namespace pg8 {
constexpr int BM = 256, BK = 64, HALF = 128, HTB = HALF * BK * 2, STAGE_BYTES = 8 * HTB, NXCD = 8, WGM = 8;
__device__ __forceinline__ int lds_byte(int r, int c) { const int st = (r >> 4) * 2 + (c >> 5), rr = r & 15, cc = c & 31, ob = rr * 64 + cc * 2; return st * 1024 + (ob ^ (((ob >> 9) & 1) << 5)); }
__device__ __forceinline__ void stage_rc(int b, int& R, int& C) { const int st = b / 1024, sb = b % 1024, swz = sb ^ (((sb >> 9) & 1) << 5); R = (st >> 1) * 16 + swz / 64; C = (st & 1) * 32 + (swz % 64) / 2; }
__device__ __forceinline__ int perm32(int rho) { const int n = rho >> 4, i = rho & 15; return 8 * (i >> 2) + 4 * n + (i & 3); }
struct Unit { int pm, pn; };
struct Gemm { const bf16_t* A; const bf16_t* Bt; int M, N, K; };
struct StaticOrder {
    int nM, nN, nwg, G, c;
    __device__ void init(int M, int N, int G_, int c_) { nM = M / BM; nN = N / BM; nwg = nM * nN; G = G_; c = c_; }
    __device__ bool next(int i, Unit& u) const {
        const long L = (long)i * G + c; if (L >= nwg) return false;
        int wgid = (int)L; { const int q = nwg / NXCD, r = nwg % NXCD, xcd = wgid % NXCD, off = wgid / NXCD; wgid = (xcd < r ? xcd * (q + 1) : r * (q + 1) + (xcd - r) * q) + off; }
        const int nig = WGM * nN, gid = wgid / nig, fm = gid * WGM, gsz = (nM - fm) < WGM ? (nM - fm) : WGM;
        u.pm = fm + ((wgid % nig) % gsz); u.pn = (wgid % nig) / gsz; return true;
    }
};
template <class Epi>
__device__ __forceinline__ void gemm_phase(LAS unsigned char* lds, const Gemm g, const StaticOrder& S, const Epi& E, int wave) {
    const int tid = fresh_tid(wave), wid = __builtin_amdgcn_readfirstlane(tid >> 6), lane = tid & 63, wr = wid >> 2, wc = wid & 3, fr = lane & 15, fq = lane >> 4;
    const int K = g.K, nt = K / BK;
    unsigned voffA[2], voffB[2];
#pragma unroll
    for (int i = 0; i < 2; ++i) { int R, C; stage_rc(tid * 16 + i * 8192, R, C); const int Rb = Epi::PERM ? ((R & ~31) + perm32(R & 31)) : R;
        voffA[i] = (unsigned)(R * K + C) * 2u; voffB[i] = (unsigned)(Rb * K + C) * 2u; }
    const size_t kstep = (size_t)(BK * 2);
    const size_t hstep = (size_t)HALF * K * 2;
    const size_t tstep = 2 * hstep;
    const unsigned ldsw = (unsigned)wid * 1024u;
    const int aoff = lds_byte(wr * 64 + fr, fq * 8), boff = lds_byte(wc * 32 + fr, fq * 8);
#define PG8_SA(b, h) (((b) * 2 + (h)) * HTB)
#define PG8_SB(b, h) ((4 + (b) * 2 + (h)) * HTB)
#define PG8_STAGE(bufoff, gbase, voff) do { _Pragma("unroll") for (int _i = 0; _i < 2; ++_i) \
        __builtin_amdgcn_global_load_lds((const unsigned*)((const char*)(gbase) + (voff)[_i]), (LAS unsigned*)(lds + (bufoff) + ldsw + _i * 8192), 16, 0, 0); } while (0)
#define PG8_LDA(dst, b, h) do { _Pragma("unroll") for (int m = 0; m < 4; ++m) _Pragma("unroll") for (int k = 0; k < 2; ++k) dst[m][k] = *(const LAS bf16x8*)(lds + PG8_SA(b, h) + aoff + m * 2048 + k * 1024); } while (0)
#define PG8_LDB(dst, b, h) do { _Pragma("unroll") for (int n = 0; n < 2; ++n) _Pragma("unroll") for (int k = 0; k < 2; ++k) dst[n][k] = *(const LAS bf16x8*)(lds + PG8_SB(b, h) + boff + n * 2048 + k * 1024); } while (0)
#define PG8_MMA(ai, bj, At, Bt) do { __builtin_amdgcn_s_setprio(1); _Pragma("unroll") for (int m = 0; m < 4; ++m) _Pragma("unroll") for (int n = 0; n < 2; ++n) _Pragma("unroll") for (int k = 0; k < 2; ++k) \
        acc[ai][bj][m][n] = __builtin_amdgcn_mfma_f32_16x16x32_bf16(Bt[n][k], At[m][k], acc[ai][bj][m][n], 0, 0, 0); __builtin_amdgcn_s_setprio(0); } while (0)
#define PG8_WAIT_V(n) asm volatile("s_waitcnt vmcnt(" #n ")" ::: "memory")
#define PG8_WAIT_L(n) asm volatile("s_waitcnt lgkmcnt(" #n ")" ::: "memory")
#define PG8_BAR __builtin_amdgcn_s_barrier()
#define PG8_SCHED __builtin_amdgcn_sched_barrier(0)
    Unit cur, nxt; int ui = 0;
    if (!S.next(0, cur)) return;
    f32x4 acc[2][2][4][2];
#pragma unroll
    for (int a = 0; a < 2; ++a)
#pragma unroll
        for (int b = 0; b < 2; ++b)
#pragma unroll
            for (int m = 0; m < 4; ++m)
#pragma unroll
                for (int n = 0; n < 2; ++n) acc[a][b][m][n] = (f32x4){0.f, 0.f, 0.f, 0.f};
    bf16x8 At[4][2], B0[2][2], B1[2][2];
    const char* cA = (const char*)g.A + (size_t)cur.pm * tstep; const char* cB = (const char*)g.Bt + (size_t)cur.pn * tstep;
    PG8_STAGE(PG8_SB(0, 0), cB, voffB); PG8_STAGE(PG8_SA(0, 0), cA, voffA); PG8_STAGE(PG8_SB(0, 1), cB + hstep, voffB); PG8_STAGE(PG8_SA(0, 1), cA + hstep, voffA);
    if (wr == 1) PG8_BAR;
    PG8_WAIT_V(4); PG8_BAR;
    PG8_STAGE(PG8_SB(1, 0), cB + kstep, voffB); PG8_STAGE(PG8_SA(1, 0), cA + kstep, voffA); PG8_STAGE(PG8_SB(1, 1), cB + hstep + kstep, voffB);
    PG8_WAIT_V(6); PG8_BAR;
    for (;;) {
        const bool has_next = S.next(ui + 1, nxt);
        const char* nA = has_next ? (const char*)g.A + (size_t)nxt.pm * tstep : cA; const char* nB = has_next ? (const char*)g.Bt + (size_t)nxt.pn * tstep : cB;
        for (int t = 0; t < nt; t += 2) {
            const bool last = (t == nt - 2);
            const char* a1 = cA + (size_t)(t + 1) * kstep;
            const char* a2 = last ? nA : cA + (size_t)(t + 2) * kstep; const char* b2 = last ? nB : cB + (size_t)(t + 2) * kstep;
            const char* a3 = a2 + kstep; const char* b3 = b2 + kstep;
            PG8_LDB(B0, 0, 0); PG8_SCHED; PG8_LDA(At, 0, 0); PG8_STAGE(PG8_SA(1, 1), a1 + hstep, voffA);
            PG8_WAIT_L(8); PG8_BAR; PG8_WAIT_L(0); PG8_MMA(0, 0, At, B0); PG8_BAR; PG8_SCHED;
            PG8_LDB(B1, 0, 1); PG8_STAGE(PG8_SB(0, 0), b2, voffB);
            PG8_BAR; PG8_WAIT_L(0); PG8_MMA(0, 1, At, B1); PG8_BAR;
            PG8_LDA(At, 0, 1); PG8_STAGE(PG8_SA(0, 0), a2, voffA);
            PG8_BAR; PG8_WAIT_L(0); PG8_MMA(1, 0, At, B0); PG8_BAR; PG8_SCHED;
            PG8_STAGE(PG8_SB(0, 1), b2 + hstep, voffB);
            PG8_WAIT_V(6); PG8_BAR; PG8_MMA(1, 1, At, B1); PG8_BAR;
            PG8_LDB(B0, 1, 0); PG8_SCHED; PG8_LDA(At, 1, 0); PG8_STAGE(PG8_SA(0, 1), a2 + hstep, voffA);
            PG8_WAIT_L(8); PG8_BAR; PG8_WAIT_L(0); PG8_MMA(0, 0, At, B0); PG8_BAR; PG8_SCHED;
            PG8_LDB(B1, 1, 1); PG8_STAGE(PG8_SB(1, 0), b3, voffB);
            PG8_BAR; PG8_WAIT_L(0); PG8_MMA(0, 1, At, B1); PG8_BAR;
            PG8_LDA(At, 1, 1); PG8_STAGE(PG8_SA(1, 0), a3, voffA);
            PG8_BAR; PG8_WAIT_L(0); PG8_MMA(1, 0, At, B0); PG8_BAR; PG8_SCHED;
            PG8_STAGE(PG8_SB(1, 1), b3 + hstep, voffB);
            PG8_WAIT_V(6); PG8_BAR; PG8_MMA(1, 1, At, B1); PG8_BAR;
        }
        E(acc, cur, wr, wc, fr, fq);
        if (!has_next) break;
#pragma unroll
        for (int a = 0; a < 2; ++a)
#pragma unroll
            for (int b = 0; b < 2; ++b)
#pragma unroll
                for (int m = 0; m < 4; ++m)
#pragma unroll
                    for (int n = 0; n < 2; ++n) acc[a][b][m][n] = (f32x4){0.f, 0.f, 0.f, 0.f};
        cur = nxt; cA = nA; cB = nB; ++ui;
    }
    PG8_WAIT_V(0);
    if (wr == 0) PG8_BAR;
    PG8_BAR;
#undef PG8_SA
#undef PG8_SB
#undef PG8_STAGE
#undef PG8_LDA
#undef PG8_LDB
#undef PG8_MMA
#undef PG8_WAIT_V
#undef PG8_WAIT_L
#undef PG8_BAR
#undef PG8_SCHED
}
}
using pg8::HALF;

struct EpiProj {
    static constexpr bool PERM = true;
    bf16_t* uhy; bf16_t* qkv;
    __device__ __forceinline__ void operator()(const f32x4 (&acc)[2][2][4][2], const pg8::Unit& u, int wr, int wc, int, int) const {
        int ln_; asm volatile("v_mbcnt_lo_u32_b32 %0, -1, 0\n\tv_mbcnt_hi_u32_b32 %0, -1, %0" : "=v"(ln_)); const int fr = ln_ & 15, fq = ln_ >> 4;
        const int row0 = u.pm * 256 + wr * 64 + fr;
        if (u.pn < 6) {
            bf16_t* cp = uhy + (size_t)(u.pn * 256 + wc * 32 + 8 * fq) * NTOK + row0;
#pragma unroll
            for (int bj = 0; bj < 2; ++bj)
#pragma unroll
                for (int n = 0; n < 2; ++n)
#pragma unroll
                    for (int j = 0; j < 4; ++j) { bf16_t* q = cp + (size_t)(bj * HALF + 4 * n + j) * NTOK;
#pragma unroll
                        for (int ai = 0; ai < 2; ++ai)
#pragma unroll
                            for (int m = 0; m < 4; ++m) q[ai * HALF + m * 16] = f2bf(acc[ai][bj][m][n][j]);
                        asm volatile("" ::: "memory"); }
        } else {
            const int col0 = (u.pn - 6) * 256 + wc * 32 + 8 * fq;
#pragma unroll
            for (int ai = 0; ai < 2; ++ai)
#pragma unroll
                for (int m = 0; m < 4; ++m) { bf16_t* rowp = qkv + (size_t)(row0 + ai * HALF + m * 16) * 1536 + col0;
#pragma unroll
                    for (int bj = 0; bj < 2; ++bj) { const f32x4 v0 = acc[ai][bj][m][0], v1 = acc[ai][bj][m][1];
                        u32x4 w; w.x = pk2(v0[0], v0[1]); w.y = pk2(v0[2], v0[3]); w.z = pk2(v1[0], v1[1]); w.w = pk2(v1[2], v1[3]);
                        *(u32x4*)(rowp + bj * HALF) = w; } }
        }
    }
};
struct EpiRes {
    static constexpr bool PERM = false;
    const float* basep; const float* bases; float* out; const float* gate;
    __device__ __forceinline__ void operator()(const f32x4 (&acc)[2][2][4][2], const pg8::Unit& u, int wr, int wc, int, int) const {
        int ln_; asm volatile("v_mbcnt_lo_u32_b32 %0, -1, 0\n\tv_mbcnt_hi_u32_b32 %0, -1, %0" : "=v"(ln_)); const int fr = ln_ & 15, fq = ln_ >> 4;
        const int row0 = u.pm * 256 + wr * 64 + fr, col0 = u.pn * 256 + wc * 32 + 4 * fq;
        const int bi = batch_of(u.pm * 256);
        const float* base = (u.pm * 256 < NPTOK) ? basep : bases - (size_t)NPTOK * D;
        f32x4 gv[2][2];
#pragma unroll
        for (int bj = 0; bj < 2; ++bj)
#pragma unroll
            for (int n = 0; n < 2; ++n) gv[bj][n] = *(const f32x4*)(gate + (size_t)bi * MODW + col0 + bj * HALF + n * 16);
#pragma unroll
        for (int ai = 0; ai < 2; ++ai) {
            f32x4 bv[4][2][2];
#pragma unroll
            for (int m = 0; m < 4; ++m) { const size_t off = (size_t)(row0 + ai * HALF + m * 16) * D + col0;
#pragma unroll
                for (int bj = 0; bj < 2; ++bj)
#pragma unroll
                    for (int n = 0; n < 2; ++n) bv[m][bj][n] = *(const f32x4*)(base + off + bj * HALF + n * 16); }
#pragma unroll
            for (int m = 0; m < 4; ++m) { const size_t off = (size_t)(row0 + ai * HALF + m * 16) * D + col0;
#pragma unroll
                for (int bj = 0; bj < 2; ++bj)
#pragma unroll
                    for (int n = 0; n < 2; ++n) *(f32x4*)(out + off + bj * HALF + n * 16) = bv[m][bj][n] + gv[bj][n] * acc[ai][bj][m][n]; }
        }
    }
};
__device__ __forceinline__ float gelu_tanh(float x) { const float t = x * x; const float z = x * (2.3022082f + 0.10294324f * t);
    const float e = __builtin_amdgcn_exp2f(z); const float r = __builtin_amdgcn_rcpf(e + 1.f); return x - x * r; }
constexpr int NEDGE = NTOK / 64 * 2;
constexpr size_t WS_SBP = WS_RC, WS_SBU = WS_RC + 32 * MiB, WS_SBG = WS_RC + 64 * MiB;
struct EpiGUF {
    static constexpr bool PERM = true;
    bf16_t* act; float* sbp; float* sbu; float* sbg; const float* cw; const float* cb; float* lw;
    __device__ __forceinline__ void operator()(f32x4 (&acc)[2][2][4][2], const pg8::Unit& u, int wr, int wc, int, int) const {
        int ln_; asm volatile("v_mbcnt_lo_u32_b32 %0, -1, 0\n\tv_mbcnt_hi_u32_b32 %0, -1, %0" : "=v"(ln_)); const int fr = ln_ & 15, fq = ln_ >> 4;
        const int lprev4 = ((ln_ & 48) | ((fr + 15) & 15)) << 2, lnext4 = ((ln_ & 48) | ((fr + 1) & 15)) << 2;
        const int f0 = u.pn * 128 + wc * 32 + 8 * fq;
        float* lwv = lw + (wr * 4 + wc) * 128;
        { const int p0 = ln_ >> 5, col = ln_ & 31, fb = u.pn * 128 + wc * 32;
          const float a_ = cw[p0 * DFF + fb + col]; const float b_ = (p0 == 0) ? cw[2 * DFF + fb + col] : cb[fb + col];
          lwv[p0 * 32 + col] = a_; lwv[(p0 + 2) * 32 + col] = b_; }
        asm volatile("s_waitcnt lgkmcnt(0)" ::: "memory");
#pragma unroll
        for (int ai = 0; ai < 2; ++ai) {
            const int rband = u.pm * 256 + ai * HALF + wr * 64;
#pragma unroll
            for (int n = 0; n < 2; ++n) {
                const bool efirst = (fr == 0), elast = (fr == 15);
                f32x4 eP, eG;
                const size_t eo = (size_t)((rband >> 6) * 2 + (elast ? 1 : 0)) * DFF + f0 + 4 * n;
                if (efirst || elast) { f32x4 eU;
#pragma unroll
                    for (int j = 0; j < 4; ++j) eU[j] = efirst ? acc[ai][1][0][n][j] : acc[ai][1][3][n][j];
                    *(f32x4*)(sbu + eo) = eU; }
#pragma unroll
                for (int j = 0; j < 4; ++j) {
                    const int lc = 8 * fq + 4 * n + j; const float w0 = lwv[lc], w1 = lwv[32 + lc], w2 = lwv[64 + lc], bb = lwv[96 + lc];
                    float gp[4], gn[4];
#pragma unroll
                    for (int m = 0; m < 4; ++m) { const int gi_ = __float_as_int(acc[ai][0][m][n][j]); gp[m] = __int_as_float(__builtin_amdgcn_ds_bpermute(lprev4, gi_)); gn[m] = __int_as_float(__builtin_amdgcn_ds_bpermute(lnext4, gi_)); }
                    float pre0 = 0.f, pre3 = 0.f;
#pragma unroll
                    for (int m = 0; m < 4; ++m) {
                        const float g = acc[ai][0][m][n][j], uv = acc[ai][1][m][n][j];
                        const float pv = (fr == 0) ? (m > 0 ? gp[m > 0 ? m - 1 : 0] : 0.f) : gp[m];
                        const float nv = (fr == 15) ? (m < 3 ? gn[m < 3 ? m + 1 : 3] : 0.f) : gn[m];
                        const float pre = w0 * pv + w1 * g + w2 * nv + bb;
                        if (m == 0) pre0 = pre;
                        if (m == 3) pre3 = pre;
                        acc[ai][1][m][n][j] = gelu_tanh(pre) * uv;
                    }
                    eP[j] = efirst ? pre0 : pre3;
                    __builtin_amdgcn_sched_barrier(0);
                }
#pragma unroll
                for (int j = 0; j < 4; ++j) eG[j] = efirst ? acc[ai][0][0][n][j] : acc[ai][0][3][n][j];
                if (efirst || elast) { *(f32x4*)(sbp + eo) = eP; *(f32x4*)(sbg + eo) = eG; }
            }
#pragma unroll
            for (int m = 0; m < 4; ++m) { bf16_t* rowp = act + (size_t)(rband + m * 16 + fr) * DFF + f0;
                const f32x4 v0 = acc[ai][1][m][0], v1 = acc[ai][1][m][1];
                u32x4 w; w.x = pk2(v0[0], v0[1]); w.y = pk2(v0[2], v0[3]); w.z = pk2(v1[0], v1[1]); w.w = pk2(v1[2], v1[3]);
                *(u32x4*)rowp = w; }
        }
    }
};
__device__ void transpose_tile(const float* src, bf16_t* dst, int K, int N, int k0, int n0, int drow0, float* tile  , int wave) {
    const int tid = fresh_tid(wave);
    __syncthreads();
#pragma unroll
    for (int i = 0; i < 2; ++i) { const int kk = (tid >> 4) + 32 * i, n4 = (tid & 15) * 4;
        const f32x4 v = *(const f32x4*)(src + (size_t)(k0 + kk) * N + n0 + n4);
        tile[kk * 65 + n4 + 0] = v[0]; tile[kk * 65 + n4 + 1] = v[1]; tile[kk * 65 + n4 + 2] = v[2]; tile[kk * 65 + n4 + 3] = v[3]; }
    __syncthreads();
    const int nn = tid >> 3, k8 = (tid & 7) * 8;
    u32x4 w; w.x = pk2(tile[(k8 + 0) * 65 + nn], tile[(k8 + 1) * 65 + nn]); w.y = pk2(tile[(k8 + 2) * 65 + nn], tile[(k8 + 3) * 65 + nn]);
    w.z = pk2(tile[(k8 + 4) * 65 + nn], tile[(k8 + 5) * 65 + nn]); w.w = pk2(tile[(k8 + 6) * 65 + nn], tile[(k8 + 7) * 65 + nn]);
    *(u32x4*)(dst + (size_t)(drow0 + nn) * K + k0 + k8) = w;
}
__device__ void mod_item(const Params& p, int item, float* lds, int wave) {
    const int tid = fresh_tid(wave), col = tid & 63, kg = tid >> 6, col0 = item * 64;
    float* mod = (float*)(p.ws + WS_MOD);
    float acc[NB];
#pragma unroll
    for (int b = 0; b < NB; ++b) acc[b] = 0.f;
    for (int half = 0; half < 2; ++half) {
        __syncthreads();
        for (int e = tid; e < NB * 512; e += NTHR) { const int b = e >> 9, kk = e & 511;
            const float c = b < 32 ? p.c_prompt[b * D + half * 512 + kk] : p.c_sample[half * 512 + kk];
            lds[kk * 36 + b] = c / (1.f + __expf(-c)); }
        __syncthreads();
        for (int kk = kg * 64; kk < kg * 64 + 64; ++kk) {
            const float w = p.ada_w[(size_t)(half * 512 + kk) * MODW + col0 + col];
#pragma unroll
            for (int b = 0; b < NB; ++b) acc[b] += lds[kk * 36 + b] * w;
        }
    }
    __syncthreads();
#pragma unroll
    for (int b = 0; b < NB; ++b) lds[(kg * NB + b) * 64 + col] = acc[b];
    __syncthreads();
    for (int e = tid; e < NB * 64; e += NTHR) { const int b = e >> 6, cc = e & 63; float s = 0.f;
#pragma unroll
        for (int k = 0; k < 8; ++k) s += lds[(k * NB + b) * 64 + cc];
        mod[b * MODW + col0 + cc] = s + p.ada_b[col0 + cc]; }
}
__device__ __forceinline__ void filt_item(const Params& p, int lsel, int tile, float* lds, int wave, float (&colsum)[16], bool flush) {
    const int tid = fresh_tid(wave);
    const int L = lsel ? TS : TP; const int t0 = tile * 16;
    float* filt = (float*)(p.ws + (lsel ? WS_FILTS : WS_FILTP));
    float* normsum = (float*)(p.ws + WS_NORM) + lsel * 2048;
    float* feat = lds;
    float* h1 = lds + 16 * 36;
    float* h2 = h1 + 16 * 64;
    __syncthreads();
    if (tid < 16 * 17) { const int t = tid / 17, j = tid % 17; const int tt = t0 + t;
        if (j == 16) feat[t * 36] = (float)tt / (float)(L - 1);
        else { const float band = 1e-4f + (float)j * ((15.0f - 1e-4f) / 15.0f);
            double turns = (double)tt * (double)band / (double)L; turns -= floor(turns);
            float s, c; sincospif((float)(2.0 * turns), &s, &c);
            feat[t * 36 + 1 + j] = c; feat[t * 36 + 17 + j] = s; } }
    __syncthreads();
    for (int e = tid; e < 1024; e += NTHR) { const int t = e >> 6, k = e & 63; float a = p.hy_pos_b1[k];
        for (int f = 0; f < 33; ++f) a += feat[t * 36 + f] * p.hy_pos_w1[f * 64 + k];
        h1[t * 64 + k] = sinf(p.hy_sin_freq[k] * a); }
    __syncthreads();
    for (int e = tid; e < 1024; e += NTHR) { const int t = e >> 6, k = e & 63; float a = p.hy_pos_b2[k];
        for (int j = 0; j < 64; ++j) a += h1[t * 64 + j] * p.hy_pos_w2[j * 64 + k];
        h2[t * 64 + k] = sinf(p.hy_sin_freq[64 + k] * a); }
    __syncthreads();
    {
        const int lane = tid & 63, l15 = lane & 15, g = lane >> 4, wv = tid >> 6;
        float av[16];
#pragma unroll
        for (int s_ = 0; s_ < 16; ++s_) av[s_] = h2[l15 * 64 + 4 * s_ + g];
        const float inv_lm1 = 1.f / (float)(L - 1);
#pragma unroll
        for (int ct = 0; ct < 16; ++ct) {
            const int col = wv * 256 + ct * 16 + l15;
            const float* wp = p.hy_pos_w3 + (size_t)g * 2048 + col;
            f32x4 acc = (f32x4){0.f, 0.f, 0.f, 0.f};
#pragma unroll
            for (int s_ = 0; s_ < 16; ++s_) acc = __builtin_amdgcn_mfma_f32_16x16x4f32(av[s_], wp[(size_t)s_ * 4 * 2048], acc, 0, 0, 0);
            const float dec = fabsf(p.hy_decay[col]); float asum = 0.f;
#pragma unroll
            for (int r = 0; r < 4; ++r) { const float tn = (float)(t0 + 4 * g + r) * inv_lm1; acc[r] *= __expf(-tn * dec); asum += fabsf(acc[r]); }
            *(f32x4*)(filt + (size_t)col * L + t0 + 4 * g) = acc;
            colsum[ct] += asum;
            if (flush) { float tot = colsum[ct]; tot += __shfl_xor(tot, 16); tot += __shfl_xor(tot, 32); if (g == 0) atomicAdd(normsum + col, tot); colsum[ct] = 0.f; }
        }
    }
}
constexpr int N_FILT_ITEMS = TP / 16 + TS / 16;
constexpr int N_MOD_ITEMS = MODW / 64;
constexpr int NT_WIN = 16 * 48, NT_WOUT = 16 * 16, NT_G = 16 * 44, NT_D = 44 * 16;
constexpr int N_TR_ITEMS = NT_WIN + NT_WOUT + 2 * NT_G + NT_D;
__device__ void phase_prep(const Params& p, float* lds, int wave) {
    const int total = N_FILT_ITEMS + N_MOD_ITEMS + N_TR_ITEMS;
    float colsum[16];
#pragma unroll
    for (int i = 0; i < 16; ++i) colsum[i] = 0.f;
    for (int it = blockIdx.x; it < total; it += gridDim.x) {
        if (it < N_FILT_ITEMS) { const bool longf = it < TS / 16; const int nx = it + gridDim.x;
            const bool flush = !(nx < N_FILT_ITEMS && ((nx < TS / 16) == longf));
            filt_item(p, longf ? 1 : 0, longf ? it : it - TS / 16, lds, wave, colsum, flush); }
        else if (it < N_FILT_ITEMS + N_MOD_ITEMS) mod_item(p, it - N_FILT_ITEMS, lds, wave);
        else { int q = it - N_FILT_ITEMS - N_MOD_ITEMS;
            if (q < NT_WIN) transpose_tile(p.w_in, (bf16_t*)(p.ws + WS_WIN), 1024, 3072, (q / 48) * 64, (q % 48) * 64, (q % 48) * 64, lds, wave);
            else if ((q -= NT_WIN) < NT_WOUT) transpose_tile(p.w_out, (bf16_t*)(p.ws + WS_WOUT), 1024, 1024, (q / 16) * 64, (q % 16) * 64, (q % 16) * 64, lds, wave);
            else if ((q -= NT_WOUT) < NT_G) { const int n0 = (q % 44) * 64; transpose_tile(p.ffn_w_gate, (bf16_t*)(p.ws + WS_WGU), 1024, DFF, (q / 44) * 64, n0, (n0 >> 7) * 256 + (n0 & 127), lds, wave); }
            else if ((q -= NT_G) < NT_G) { const int n0 = (q % 44) * 64; transpose_tile(p.ffn_w_up, (bf16_t*)(p.ws + WS_WGU), 1024, DFF, (q / 44) * 64, n0, (n0 >> 7) * 256 + 128 + (n0 & 127), lds, wave); }
            else { q -= NT_G; transpose_tile(p.ffn_w_down, (bf16_t*)(p.ws + WS_WD), DFF, 1024, (q / 16) * 64, (q % 16) * 64, (q % 16) * 64, lds, wave); }
        }
    }
}

__device__ void phase_hrows(const Params& p, const float* srcp, const float* srcs, const float* gamma, int sh_off, int sc_off, bf16_t* h, int wave) {
    const int tid = fresh_tid(wave); const int lane = tid & 63, wv = tid >> 6;
    const float* mod = (const float*)(p.ws + WS_MOD);
    const int stride = gridDim.x * 8;
    for (int g0 = blockIdx.x * 8 + wv; g0 < NTOK; g0 += 2 * stride) {
        f32x4 v[2][4]; float ss[2];
#pragma unroll
        for (int u = 0; u < 2; ++u) { const int g = g0 + u * stride; ss[u] = 0.f;
            if (g < NTOK) { const float* x = g < NPTOK ? srcp + (size_t)g * D : srcs + (size_t)(g - NPTOK) * D;
#pragma unroll
                for (int i = 0; i < 4; ++i) v[u][i] = *(const f32x4*)(x + lane * 8 + 512 * (i >> 1) + 4 * (i & 1)); } }
#pragma unroll
        for (int u = 0; u < 2; ++u) { const int g = g0 + u * stride;
            if (g < NTOK) {
#pragma unroll
                for (int i = 0; i < 4; ++i) ss[u] += v[u][i][0] * v[u][i][0] + v[u][i][1] * v[u][i][1] + v[u][i][2] * v[u][i][2] + v[u][i][3] * v[u][i][3];
#pragma unroll
                for (int o = 32; o >= 1; o >>= 1) ss[u] += __shfl_xor(ss[u], o);
                const float r = rsqrtf(ss[u] * (1.f / D) + EPS); const int b = batch_of(g);
#pragma unroll
                for (int i2 = 0; i2 < 2; ++i2) { const int c = lane * 8 + 512 * i2; u32x4 w;
#pragma unroll
                    for (int hf = 0; hf < 2; ++hf) { const int cc = c + 4 * hf;
                        const f32x4 gm = *(const f32x4*)(gamma + cc), sc = *(const f32x4*)(mod + b * MODW + sc_off + cc), sh = *(const f32x4*)(mod + b * MODW + sh_off + cc);
                        const f32x4 y = v[u][2 * i2 + hf] * r * gm * (sc + 1.f) + sh;
                        w[2 * hf] = pk2(y[0], y[1]); w[2 * hf + 1] = pk2(y[2], y[3]); }
                    *(u32x4*)(h + (size_t)g * D + c) = w; } } }
    }
}
__device__ void phase_final(const Params& p, int wave) {
    const int tid = fresh_tid(wave); const int lane = tid & 63, wv = tid >> 6;
    const int stride = gridDim.x * 8;
    for (int g0 = blockIdx.x * 8 + wv; g0 < NTOK; g0 += 2 * stride) {
        f32x4 v[2][4]; float ss[2];
#pragma unroll
        for (int u = 0; u < 2; ++u) { const int g = g0 + u * stride; ss[u] = 0.f;
            if (g < NTOK) { const float* x = p.out + (size_t)g * D;
#pragma unroll
                for (int i = 0; i < 4; ++i) v[u][i] = *(const f32x4*)(x + lane * 8 + 512 * (i >> 1) + 4 * (i & 1)); } }
#pragma unroll
        for (int u = 0; u < 2; ++u) { const int g = g0 + u * stride;
            if (g < NTOK) { float* x = p.out + (size_t)g * D;
#pragma unroll
                for (int i = 0; i < 4; ++i) ss[u] += v[u][i][0] * v[u][i][0] + v[u][i][1] * v[u][i][1] + v[u][i][2] * v[u][i][2] + v[u][i][3] * v[u][i][3];
#pragma unroll
                for (int o = 32; o >= 1; o >>= 1) ss[u] += __shfl_xor(ss[u], o);
                const float r = rsqrtf(ss[u] * (1.f / D) + EPS);
#pragma unroll
                for (int i = 0; i < 4; ++i) { const int c = lane * 8 + 512 * (i >> 1) + 4 * (i & 1); *(f32x4*)(x + c) = v[u][i] * r * *(const f32x4*)(p.final_g + c); } } }
    }
}
__device__ void phase_fix(const Params& p, bf16_t* act, int wave) {
    const int tid = fresh_tid(wave);
    const float* sbp = (const float*)(p.ws + WS_SBP); const float* sbu = (const float*)(p.ws + WS_SBU); const float* sbg = (const float*)(p.ws + WS_SBG);
    constexpr int per_row = DFF / 4;
    for (int e = blockIdx.x * NTHR + tid; e < NEDGE * per_row; e += gridDim.x * NTHR) {
        const int idx = e / per_row, f = (e % per_row) * 4;
        const int r = (idx >> 1) * 64 + ((idx & 1) ? 63 : 0);
        const int t = r < NPTOK ? (r & (TP - 1)) : r - NPTOK; const int T = r < NPTOK ? TP : TS;
        f32x4 pre = *(const f32x4*)(sbp + (size_t)idx * DFF + f);
        const f32x4 uu = *(const f32x4*)(sbu + (size_t)idx * DFF + f);
        if (!(idx & 1)) { if (t > 0) pre += *(const f32x4*)(p.ffn_conv_w + f) * *(const f32x4*)(sbg + (size_t)(idx - 1) * DFF + f); }
        else { if (t < T - 1) pre += *(const f32x4*)(p.ffn_conv_w + 2 * DFF + f) * *(const f32x4*)(sbg + (size_t)(idx + 1) * DFF + f); }
        u32x2 w; w.x = pk2(gelu_tanh(pre[0]) * uu[0], gelu_tanh(pre[1]) * uu[1]); w.y = pk2(gelu_tanh(pre[2]) * uu[2], gelu_tanh(pre[3]) * uu[3]);
        *(u32x2*)(act + (size_t)r * DFF + f) = w;
    }
}

#define LP(i) ((i) + ((i) >> 3))
__device__ __forceinline__ c2 cmul(c2 a, c2 b) { return (c2){a.x * b.x - a.y * b.y, a.x * b.y + a.y * b.x}; }
__device__ __forceinline__ c2 cmulc(c2 a, c2 b) { return (c2){a.x * b.x + a.y * b.y, a.y * b.x - a.x * b.y}; }
__device__ __forceinline__ c2 mni(c2 a) { return (c2){a.y, -a.x}; }
__device__ __forceinline__ void dft8(c2 (&x)[8]) {
    const float s = 0.70710678118654752f;
    const c2 a0 = x[0] + x[4], a4 = x[0] - x[4], a1 = x[1] + x[5], a5 = x[1] - x[5], a2 = x[2] + x[6], a6 = x[2] - x[6], a3 = x[3] + x[7], a7 = x[3] - x[7];
    const c2 a5w = (c2){(a5.x + a5.y) * s, (a5.y - a5.x) * s};
    const c2 a6w = mni(a6);
    const c2 a7w = (c2){(a7.y - a7.x) * s, -(a7.x + a7.y) * s};
    const c2 b0 = a0 + a2, b1 = a0 - a2, b2 = a1 + a3, b3 = mni(a1 - a3);
    x[0] = b0 + b2; x[4] = b0 - b2; x[2] = b1 + b3; x[6] = b1 - b3;
    const c2 c0 = a4 + a6w, c1 = a4 - a6w, c2_ = a5w + a7w, c3 = mni(a5w - a7w);
    x[1] = c0 + c2_; x[5] = c0 - c2_; x[3] = c1 + c3; x[7] = c1 - c3;
}
__device__ __forceinline__ c2 mpi(c2 a) { return (c2){-a.y, a.x}; }
__device__ __forceinline__ void idft8(c2 (&x)[8]) {
    const float s = 0.70710678118654752f;
    const c2 a0 = x[0] + x[4], a4 = x[0] - x[4], a1 = x[1] + x[5], a5 = x[1] - x[5], a2 = x[2] + x[6], a6 = x[2] - x[6], a3 = x[3] + x[7], a7 = x[3] - x[7];
    const c2 a5w = (c2){(a5.x - a5.y) * s, (a5.x + a5.y) * s};
    const c2 a6w = mpi(a6);
    const c2 a7w = (c2){-(a7.x + a7.y) * s, (a7.x - a7.y) * s};
    const c2 b0 = a0 + a2, b1 = a0 - a2, b2 = a1 + a3, b3 = mpi(a1 - a3);
    x[0] = b0 + b2; x[4] = b0 - b2; x[2] = b1 + b3; x[6] = b1 - b3;
    const c2 c0 = a4 + a6w, c1 = a4 - a6w, c2_ = a5w + a7w, c3 = mpi(a5w - a7w);
    x[1] = c0 + c2_; x[5] = c0 - c2_; x[3] = c1 + c3; x[7] = c1 - c3;
}
__device__ __forceinline__ void fwd_s0(c2 (&x)[8], c2* buf, const c2* tws, int tid) {
    dft8(x);
#pragma unroll
    for (int q = 1; q < 8; ++q) x[q] = cmul(x[q], tws[(q - 1) * 512 + tid]);
    { c2* bp_ = buf + LP(tid);
#pragma unroll
    for (int q = 0; q < 8; ++q) bp_[576 * q] = x[q]; }
}
template <int S> __device__ __forceinline__ void fwd_mid(c2* buf, const c2* tws, int tid) {
    constexpr int lq = 9 - 3 * S, Q = 1 << lq; const c2* T = tws + (S == 1 ? 3584 : 4032);
    const int k = tid & (Q - 1), base = ((tid >> lq) << (lq + 3)) + k;
    c2 x[8];
    c2* bp_ = buf + LP(base); constexpr int QP = Q + Q / 8;
#pragma unroll
    for (int r = 0; r < 8; ++r) x[r] = bp_[r * QP];
    dft8(x);
#pragma unroll
    for (int q = 1; q < 8; ++q) x[q] = cmul(x[q], T[(q - 1) * Q + k]);
#pragma unroll
    for (int q = 0; q < 8; ++q) bp_[q * QP] = x[q];
}
__device__ __forceinline__ void fwd_s3(c2 (&x)[8], const c2* buf, int tid) {
#pragma unroll
    for (int r = 0; r < 8; ++r) x[r] = buf[9 * tid + r];
    dft8(x);
}
__device__ __forceinline__ void inv_s3(c2 (&x)[8], c2* buf, int tid) {
    idft8(x);
#pragma unroll
    for (int q = 0; q < 8; ++q) buf[9 * tid + q] = x[q];
}
template <int S> __device__ __forceinline__ void inv_mid(c2* buf, const c2* tws, int tid) {
    constexpr int lq = 9 - 3 * S, Q = 1 << lq; const c2* T = tws + (S == 1 ? 3584 : 4032);
    const int k = tid & (Q - 1), base = ((tid >> lq) << (lq + 3)) + k;
    c2 x[8];
    c2* bp_ = buf + LP(base); constexpr int QP = Q + Q / 8;
#pragma unroll
    for (int r = 0; r < 8; ++r) { c2 v = bp_[r * QP]; if (r) v = cmulc(v, T[(r - 1) * Q + k]); x[r] = v; }
    idft8(x);
#pragma unroll
    for (int q = 0; q < 8; ++q) bp_[q * QP] = x[q];
}
__device__ __forceinline__ void inv_s0(c2 (&x)[8], const c2* buf, const c2* tws, int tid) {
    const c2* bp_ = buf + LP(tid);
#pragma unroll
    for (int r = 0; r < 8; ++r) { c2 v = bp_[576 * r]; if (r) v = cmulc(v, tws[(r - 1) * 512 + tid]); x[r] = v; }
    idft8(x);
}
__device__ __forceinline__ void fft_fwd_regs2(c2 (&x0)[8], c2 (&x1)[8], c2* buf0, c2* buf1, const c2* tws, int tid) {
    fwd_s0(x0, buf0, tws, tid); fwd_s0(x1, buf1, tws, tid); __syncthreads();
    fwd_mid<1>(buf0, tws, tid); fwd_mid<1>(buf1, tws, tid); __syncthreads();
    fwd_mid<2>(buf0, tws, tid); fwd_mid<2>(buf1, tws, tid); __syncthreads();
    fwd_s3(x0, buf0, tid); fwd_s3(x1, buf1, tid);
}
__device__ __forceinline__ void fft_inv_regs2(c2 (&x0)[8], c2 (&x1)[8], c2* buf0, c2* buf1, const c2* tws, int tid) {
    inv_s3(x0, buf0, tid); inv_s3(x1, buf1, tid); __syncthreads();
    inv_mid<2>(buf0, tws, tid); inv_mid<2>(buf1, tws, tid); __syncthreads();
    inv_mid<1>(buf0, tws, tid); inv_mid<1>(buf1, tws, tid); __syncthreads();
    inv_s0(x0, buf0, tws, tid); inv_s0(x1, buf1, tws, tid);
}
__device__ __forceinline__ float subfilt(const float* hf, const float* hb, int L, int d, int m) {
    if (m == 2048) return 0.f;
    const int l = 2048 * d + (m < 2048 ? m : m - 4096);
    if (l >= 0) return l < L ? hf[l] : 0.f;
    return -l < L ? hb[-l] : 0.f;
}
constexpr int RAWROW = 2064;
struct QuadRegs { u32x4 v[4]; unsigned h[4]; };
__device__ __forceinline__ QuadRegs quad_load(const bf16_t* zsrc, const bf16_t* gsrc, int gstart, bool joined, bool first, bool last, int tid) {
    const bf16_t* src = ((tid >> 8) ? gsrc : zsrc) + gstart; const int ci = tid & 255;
    QuadRegs R;
#pragma unroll
    for (int k = 0; k < 4; ++k) { R.v[k] = *(const u32x4*)(src + 2048 * k + 8 * ci); R.h[k] = 0u; }
    if (joined) {
        if (ci == 0) {
#pragma unroll
            for (int k = 0; k < 4; ++k) if (k > 0 || !first) R.h[k] = src[2048 * k - 1]; }
        if (ci == 255) {
#pragma unroll
            for (int k = 0; k < 4; ++k) if (k < 3 || !last) R.h[k] = src[2048 * (k + 1)]; }
    }
    return R;
}
__device__ __forceinline__ void quad_store(const QuadRegs& R, bf16_t* raw  , int tid) {
    bf16_t* base = raw + (tid >> 8) * 4 * RAWROW; const int ci = tid & 255;
#pragma unroll
    for (int k = 0; k < 4; ++k) { *(u32x4*)(base + k * RAWROW + 8 + 8 * ci) = R.v[k];
        if (ci == 0) base[k * RAWROW + 7] = (bf16_t)R.h[k];
        if (ci == 255) base[k * RAWROW + 2056] = (bf16_t)R.h[k]; }
}
__device__ __forceinline__ float dwl(const bf16_t* r, int t, float w0, float w1, float w2, float b) { return w0 * bf2f(r[7 + t]) + w1 * bf2f(r[8 + t]) + w2 * bf2f(r[9 + t]) + b; }
__device__ __forceinline__ void phase_conv(const Params& p, int o, unsigned char* smem, int wave) {
    const int tid = fresh_tid(wave);
    c2* buf0 = (c2*)smem;
    c2* buf1 = (c2*)(smem + 36864);
    c2* tws = (c2*)(smem + 73728);
    bf16_t* raw = (bf16_t*)(smem + 106496);
    const bf16_t* uhy = (const bf16_t*)(p.ws + WS_RB);
    const bf16_t* z1 = (const bf16_t*)(p.ws + WS_RD);
    bf16_t* outp = (bf16_t*)(p.ws + (o == 0 ? WS_RD : WS_RE));
    c2* scr = (c2*)(p.ws + WS_RA + (size_t)blockIdx.x * SCR_PER_BLOCK);
    const float* normsum = (const float*)(p.ws + WS_NORM);
    __syncthreads();
    for (int n = tid; n < 4088; n += NTHR) { int e;
        if (n < 3584) e = ((n >> 9) + 1) * (n & 511); else if (n < 4032) e = (((n - 3584) >> 6) + 1) * ((n - 3584) & 63) * 8; else e = (((n - 4032) >> 3) + 1) * ((n - 4032) & 7) * 64;
        float s, c; sincospif((float)e * (1.f / 2048.f), &s, &c); tws[n] = (c2){c, -s}; }
    __syncthreads();
    const bool g256 = gridDim.x == 256;
    const int nrounds = g256 ? 4 : (1024 + gridDim.x - 1) / gridDim.x;
#pragma unroll 1
    for (int rd = 0; rd < nrounds; ++rd) {
        bool samp; int c;
        if (g256) { samp = ((blockIdx.x + rd) & 1) == 0; c = (rd >> 1) * 256 + blockIdx.x; }
        else { const int it = blockIdx.x + rd * gridDim.x; if (it >= 1024) break; samp = it < 512; c = it & 511; }
        const int lsel = samp ? 1 : 0; const int L = samp ? TS : TP;
        const float* filt = (const float*)(p.ws + (samp ? WS_FILTS : WS_FILTP));
        const float* hf = filt + (size_t)((o * 2 + 0) * 512 + c) * L; const float* hb = filt + (size_t)((o * 2 + 1) * 512 + c) * L;
        const float nrm = normsum[lsel * 2048 + (o * 2) * 512 + c] + normsum[lsel * 2048 + (o * 2 + 1) * 512 + c];
        const float scale = 1.f / (4096.f * nrm);
        const float skip = p.hy_skip[o * 512 + c];
        const int zc = c, gc = (o == 0 ? 512 : 1024) + c;
        const float zw0 = p.hy_short_w[zc], zw1 = p.hy_short_w[1536 + zc], zw2 = p.hy_short_w[3072 + zc], zb = p.hy_short_b[zc];
        const float gw0 = p.hy_short_w[gc], gw1 = p.hy_short_w[1536 + gc], gw2 = p.hy_short_w[3072 + gc], gb = p.hy_short_b[gc];
        const bf16_t* grow = uhy + (size_t)gc * NTOK;
        const bf16_t* zrow = (o == 0) ? uhy + (size_t)zc * NTOK : z1 + (size_t)c * NTOK;
        bf16_t* orow = outp + (size_t)c * NTOK;
        const bf16_t* rg = raw + 4 * RAWROW;
#define ZVAL(r, t) ((o == 0) ? dwl((r), (t), zw0, zw1, zw2, zb) : bf2f((r)[8 + (t)]))
#define EPI(XV, k0, gq) do { _Pragma("unroll") for (int q = 0; q < 4; ++q) { const int t = tid + 512 * q; const c2 y = (XV)[q] * scale; \
            const float za_ = ZVAL(raw + (k0) * RAWROW, t), zb_ = ZVAL(raw + ((k0) + 1) * RAWROW, t); \
            const float ga_ = dwl(rg + (k0) * RAWROW, t, gw0, gw1, gw2, gb), gb_ = dwl(rg + ((k0) + 1) * RAWROW, t, gw0, gw1, gw2, gb); \
            orow[(gq) + (k0) * 2048 + t] = f2bf(ga_ * (y.x + skip * za_)); orow[(gq) + ((k0) + 1) * 2048 + t] = f2bf(gb_ * (y.y + skip * zb_)); } } while (0)
#define EPIZ(XV, ZK, k0, gq) do { _Pragma("unroll") for (int q = 0; q < 4; ++q) { const int t = tid + 512 * q; const c2 y = (XV)[q] * scale; \
            const float ga_ = dwl(rg + (k0) * RAWROW, t, gw0, gw1, gw2, gb), gb_ = dwl(rg + ((k0) + 1) * RAWROW, t, gw0, gw1, gw2, gb); \
            orow[(gq) + (k0) * 2048 + t] = f2bf(ga_ * (y.x + skip * (ZK)[q].x)); orow[(gq) + ((k0) + 1) * 2048 + t] = f2bf(gb_ * (y.y + skip * (ZK)[q].y)); } } while (0)
        if (!samp) {
            c2 K[8], dmy[8];
#pragma unroll
            for (int r = 0; r < 8; ++r) { K[r] = (c2){subfilt(hf, hb, L, 0, tid + 512 * r), 0.f}; dmy[r] = (c2){0.f, 0.f}; }
            __syncthreads();
            fft_fwd_regs2(K, dmy, buf0, buf1, tws, tid);
            QuadRegs R = quad_load(zrow, grow, 0, false, true, true, tid);
#pragma unroll 1
            for (int i = 0; i < 8; ++i) {
                const int gq = i * 8192;
                __syncthreads();
                quad_store(R, raw, tid);
                __syncthreads();
                if (i < 7) R = quad_load(zrow, grow, gq + 8192, false, true, true, tid);
                c2 x0[8], x1[8], zk0[4], zk1[4];
#pragma unroll
                for (int r = 0; r < 4; ++r) { const int t = tid + 512 * r;
                    x0[r] = (c2){ZVAL(raw, t), ZVAL(raw + RAWROW, t)}; x1[r] = (c2){ZVAL(raw + 2 * RAWROW, t), ZVAL(raw + 3 * RAWROW, t)}; zk0[r] = x0[r]; zk1[r] = x1[r];
                    x0[4 + r] = (c2){0.f, 0.f}; x1[4 + r] = (c2){0.f, 0.f}; }
                fft_fwd_regs2(x0, x1, buf0, buf1, tws, tid);
#pragma unroll
                for (int q = 0; q < 8; ++q) { x0[q] = cmul(x0[q], K[q]); x1[q] = cmul(x1[q], K[q]); }
                fft_inv_regs2(x0, x1, buf0, buf1, tws, tid);
                EPIZ(x0, zk0, 0, gq); EPIZ(x1, zk1, 2, gq);
            }
        } else {
            c2* sK = scr; c2* sZ = scr + 15 * 4096;
            const int gs = NPTOK;
#pragma unroll 1
            for (int d = -7; d <= 7; d += 2) {
                c2 x0[8], x1[8];
#pragma unroll
                for (int r = 0; r < 8; ++r) { x0[r] = (c2){subfilt(hf, hb, L, d, tid + 512 * r), 0.f}; x1[r] = (c2){d < 7 ? subfilt(hf, hb, L, d + 1, tid + 512 * r) : 0.f, 0.f}; }
                __syncthreads();
                fft_fwd_regs2(x0, x1, buf0, buf1, tws, tid);
#pragma unroll
                for (int q = 0; q < 8; ++q) { sK[((d + 7) * 8 + q) * 512 + tid] = x0[q]; if (d < 7) sK[((d + 8) * 8 + q) * 512 + tid] = x1[q]; }
            }
            {
                QuadRegs R = quad_load(zrow, grow, gs, true, true, false, tid);
#pragma unroll 1
                for (int a = 0; a < 2; ++a) {
                    __syncthreads();
                    quad_store(R, raw, tid);
                    __syncthreads();
                    if (a < 1) R = quad_load(zrow, grow, gs + 8192, true, false, true, tid);
#pragma unroll 1
                    for (int hh = 0; hh < 2; ++hh) {
                        c2 x0[8], x1[8];
#pragma unroll
                        for (int r = 0; r < 4; ++r) { const int t = tid + 512 * r; x0[r] = (c2){ZVAL(raw + (2 * hh) * RAWROW, t), 0.f}; x1[r] = (c2){ZVAL(raw + (2 * hh + 1) * RAWROW, t), 0.f}; x0[4 + r] = (c2){0.f, 0.f}; x1[4 + r] = (c2){0.f, 0.f}; }
                        fft_fwd_regs2(x0, x1, buf0, buf1, tws, tid);
#pragma unroll
                        for (int q = 0; q < 8; ++q) { sZ[((4 * a + 2 * hh) * 8 + q) * 512 + tid] = x0[q]; sZ[((4 * a + 2 * hh + 1) * 8 + q) * 512 + tid] = x1[q]; }
                        __syncthreads();
                    }
                }
            }
#pragma unroll 1
            for (int q = 0; q < 8; ++q) {
                c2 Z[8], Y[8];
#pragma unroll
                for (int j = 0; j < 8; ++j) { Z[j] = sZ[(j * 8 + q) * 512 + tid]; Y[j] = (c2){0.f, 0.f}; }
#pragma unroll
                for (int d = -7; d <= 7; ++d) { const c2 kd = sK[((d + 7) * 8 + q) * 512 + tid];
#pragma unroll
                    for (int i = 0; i < 8; ++i) if (i - d >= 0 && i - d < 8) Y[i] += cmul(Z[i - d], kd); }
#pragma unroll
                for (int a = 0; a < 4; ++a) sZ[(a * 8 + q) * 512 + tid] = (c2){Y[2 * a].x - Y[2 * a + 1].y, Y[2 * a].y + Y[2 * a + 1].x};
            }
            {
                QuadRegs R = quad_load(zrow, grow, gs, true, true, false, tid);
#pragma unroll 1
                for (int a = 0; a < 2; ++a) {
                    const int gq = gs + a * 8192;
                    __syncthreads();
                    quad_store(R, raw, tid);
                    __syncthreads();
                    if (a < 1) R = quad_load(zrow, grow, gs + 8192, true, false, true, tid);
                    c2 x0[8], x1[8];
#pragma unroll
                    for (int q = 0; q < 8; ++q) { x0[q] = sZ[((2 * a) * 8 + q) * 512 + tid]; x1[q] = sZ[((2 * a + 1) * 8 + q) * 512 + tid]; }
                    fft_inv_regs2(x0, x1, buf0, buf1, tws, tid);
                    EPI(x0, 0, gq); EPI(x1, 2, gq);
                }
            }
        }
#undef ZVAL
#undef EPI
#undef EPIZ
        __syncthreads();
    }
}

typedef short v4i16_t __attribute__((ext_vector_type(4)));
__device__ __forceinline__ v4i16_t lds_tr16(const bf16_t* p) { return __builtin_amdgcn_ds_read_tr16_b64_v4i16((LAS v4i16_t*)p); }
constexpr int ATT_LD = 72;
constexpr int ATT_BYTES = (128 + 256 + 256) * ATT_LD * 2;
__device__ void phase_attn(const Params& p, unsigned char* smem, int wave) {
    const int tid = fresh_tid(wave), ht = tid, w4 = tid >> 6, lane = tid & 63, ql = lane & 15, gq = lane >> 4;
    bf16_t* Qs = (bf16_t*)smem; bf16_t* Ks = Qs + 128 * ATT_LD; bf16_t* Vs = Ks + 256 * ATT_LD;
    const bf16_t* qkv = (const bf16_t*)(p.ws + WS_RC);
    float* lse = (float*)(p.ws + WS_LSE);
    const int npairs = 15360;
    u32x4 qr[2], kr[4], vr[4];
#define ATT_DECODE(pr_) \
        const int it = (pr_); \
        const int tile = it % 640, hb = it / 640, h = hb & 7, br = hb >> 3; \
        const int d = br == 0 ? 1 : (br == 1 ? 4 : 16); \
        int gbase, T, lb; \
        if (tile < 512) { gbase = (tile >> 4) * TP; T = TP; lb = tile & 15; } else { gbase = NPTOK; T = TS; lb = tile - 512; } \
        const int Ls = T / d, res = lb % d, i0 = (lb / d) * 128;
#define ATT_LOAD() do { const int ht_ = fresh_tid(wave); \
        _Pragma("unroll") for (int c_ = 0; c_ < 2; ++c_) { const int e = ht_ + 512 * c_; const int r = e >> 3, ch = e & 7; const int tok = gbase + (i0 + r) * d + res; \
            qr[c_] = *(const u32x4*)(qkv + (unsigned)(tok * 1536 + h * 64 + ch * 8)); } \
        _Pragma("unroll") for (int c_ = 0; c_ < 4; ++c_) { const int e = ht_ + 512 * c_; const int r = e >> 3, ch = e & 7; const int j = i0 - 64 + r; \
            kr[c_] = (u32x4){0u, 0u, 0u, 0u}; vr[c_] = kr[c_]; \
            if (j >= 0 && j < Ls) { const unsigned off = (unsigned)((gbase + j * d + res) * 1536 + h * 64 + ch * 8); kr[c_] = *(const u32x4*)(qkv + off + 512); vr[c_] = *(const u32x4*)(qkv + off + 1024); } } } while (0)
    if ((int)blockIdx.x < npairs) { ATT_DECODE(blockIdx.x) ATT_LOAD(); }
    for (int pr = blockIdx.x; pr < npairs; pr += gridDim.x) {
        ATT_DECODE(pr)
        bf16_t* ato = (bf16_t*)(p.ws + (br < 2 ? WS_RA + br * ATO_STRIDE_01 : WS_ATO2));
        __syncthreads();
        const int hs = fresh_tid(wave);
#pragma unroll
        for (int c_ = 0; c_ < 2; ++c_) { const int e = hs + 512 * c_; *(u32x4*)(Qs + (e >> 3) * ATT_LD + (e & 7) * 8) = qr[c_]; }
#pragma unroll
        for (int c_ = 0; c_ < 4; ++c_) { const int e = hs + 512 * c_; *(u32x4*)(Ks + (e >> 3) * ATT_LD + (e & 7) * 8) = kr[c_]; *(u32x4*)(Vs + (e >> 3) * ATT_LD + (e & 7) * 8) = vr[c_]; }
        __syncthreads();
        if (pr + (int)gridDim.x < npairs) { ATT_DECODE(pr + gridDim.x) ATT_LOAD(); }
        const bf16x8 qf0 = *(const bf16x8*)(Qs + (16 * w4 + ql) * ATT_LD + gq * 8), qf1 = *(const bf16x8*)(Qs + (16 * w4 + ql) * ATT_LD + 32 + gq * 8);
        f32x4 sc[10];
#pragma unroll
        for (int kt = 0; kt < 9; ++kt) { const bf16_t* kr = Ks + (16 * w4 + 16 * kt + ql) * ATT_LD + gq * 8;
            f32x4 a = (f32x4){0.f, 0.f, 0.f, 0.f};
            a = __builtin_amdgcn_mfma_f32_16x16x32_bf16(*(const bf16x8*)kr, qf0, a, 0, 0, 0);
            a = __builtin_amdgcn_mfma_f32_16x16x32_bf16(*(const bf16x8*)(kr + 32), qf1, a, 0, 0, 0);
            sc[kt] = a; if (kt % 3 == 2) __builtin_amdgcn_sched_barrier(0); }
        const float slope = exp2f(-(float)(h + 1)) * (float)d * 1.4426950408889634f;
        const int qi = i0 + 16 * w4 + ql;
        float mx = -1e30f;
#pragma unroll
        for (int kt = 0; kt < 9; ++kt)
#pragma unroll
            for (int j = 0; j < 4; ++j) { const int rel = 16 * kt + 4 * gq + j - 64 - ql; const int jk = qi + rel;
                const bool relok = (kt == 0) ? (rel >= -64) : ((kt == 8) ? (rel <= 64) : true);
                const bool ok = relok && ((unsigned)jk < (unsigned)Ls);
                const float v = ok ? sc[kt][j] * 0.18033688011112042f - slope * fabsf((float)rel) : -1e30f;
                sc[kt][j] = v; mx = fmaxf(mx, v); }
        mx = fmaxf(mx, __shfl_xor(mx, 16)); mx = fmaxf(mx, __shfl_xor(mx, 32));
        float den = 0.f;
#pragma unroll
        for (int kt = 0; kt < 9; ++kt)
#pragma unroll
            for (int j = 0; j < 4; ++j) { const float pv = __builtin_amdgcn_exp2f(sc[kt][j] - mx); sc[kt][j] = pv; den += pv; }
        sc[9] = (f32x4){0.f, 0.f, 0.f, 0.f};
        den += __shfl_xor(den, 16); den += __shfl_xor(den, 32);
        f32x4 oacc[4];
#pragma unroll
        for (int et = 0; et < 4; ++et) oacc[et] = (f32x4){0.f, 0.f, 0.f, 0.f};
#pragma unroll
        for (int ks = 0; ks < 5; ++ks) {
            u32x4 pu; pu.x = cvtpk(sc[2 * ks][0], sc[2 * ks][1]); pu.y = cvtpk(sc[2 * ks][2], sc[2 * ks][3]); pu.z = cvtpk(sc[2 * ks + 1][0], sc[2 * ks + 1][1]); pu.w = cvtpk(sc[2 * ks + 1][2], sc[2 * ks + 1][3]);
            const bf16x8 pf = __builtin_bit_cast(bf16x8, pu);
            const bf16_t* vrow = Vs + (16 * w4 + 32 * ks + 4 * gq + (ql >> 2)) * ATT_LD + 4 * (ql & 3);
#pragma unroll
            for (int et = 0; et < 4; ++et) {
                const v4i16_t t0 = lds_tr16(vrow + 16 * et);
                v4i16_t t1 = (v4i16_t){0, 0, 0, 0};
                if (ks < 4) t1 = lds_tr16(vrow + 16 * ATT_LD + 16 * et);
                const bf16x8 vf = __builtin_shufflevector(t0, t1, 0, 1, 2, 3, 4, 5, 6, 7);
                oacc[et] = __builtin_amdgcn_mfma_f32_16x16x32_bf16(pf, vf, oacc[et], 0, 0, 0); }
            __builtin_amdgcn_sched_barrier(0);
        }
#pragma unroll
        for (int j = 0; j < 4; ++j) { const float dq = __shfl(den, 4 * gq + j); const float inv = __builtin_amdgcn_rcpf(dq);
            const int tok = gbase + (i0 + 16 * w4 + 4 * gq + j) * d + res;
#pragma unroll
            for (int et = 0; et < 4; ++et) ato[(size_t)tok * 512 + h * 64 + 16 * et + ql] = f2bf(oacc[et][j] * inv); }
        if (gq == 0) { const int tok = gbase + qi * d + res; lse[((size_t)br * NTOK + tok) * 8 + h] = mx * 0.6931471805599453f + __logf(den); }
    }
}

__device__ void phase_mixin(const Params& p, unsigned char* smem, int wave) {
    const int tid = fresh_tid(wave);
    bf16_t* tl = (bf16_t*)smem;
    const bf16_t* hy = (const bf16_t*)(p.ws + WS_RE);
    const float* lse = (const float*)(p.ws + WS_LSE);
    bf16_t* mix = (bf16_t*)(p.ws + WS_RC);
    for (int it = blockIdx.x; it < NTOK / 64; it += gridDim.x) {
        const int g0 = it * 64;
        const int tt = tid >> 3, sub = tid & 7, g = g0 + tt;
        u32x4 tv[8], av[8], bv[8], cv[8];
        { const bf16_t* src = hy + (size_t)tid * NTOK + g0;
#pragma unroll
          for (int q = 0; q < 8; ++q) tv[q] = *(const u32x4*)(src + 8 * q); }
        const int h = sub;
        const float l0 = lse[((size_t)0 * NTOK + g) * 8 + h], l1 = lse[((size_t)1 * NTOK + g) * 8 + h], l2 = lse[((size_t)2 * NTOK + g) * 8 + h];
        { const bf16_t* o0 = (const bf16_t*)(p.ws + WS_RA) + (size_t)g * 512 + h * 64;
          const bf16_t* o1 = (const bf16_t*)(p.ws + WS_RA + ATO_STRIDE_01) + (size_t)g * 512 + h * 64;
          const bf16_t* o2 = (const bf16_t*)(p.ws + WS_ATO2) + (size_t)g * 512 + h * 64;
#pragma unroll
          for (int q = 0; q < 8; ++q) { av[q] = *(const u32x4*)(o0 + 8 * q); bv[q] = *(const u32x4*)(o1 + 8 * q); cv[q] = *(const u32x4*)(o2 + 8 * q); } }
        __syncthreads();
#pragma unroll
        for (int q = 0; q < 8; ++q) { unsigned* dst = (unsigned*)(tl + tid * 66 + 8 * q); dst[0] = tv[q].x; dst[1] = tv[q].y; dst[2] = tv[q].z; dst[3] = tv[q].w; }
        __syncthreads();
        { float ss = 0.f;
          for (int c = sub * 64; c < sub * 64 + 64; ++c) { const float v = bf2f(tl[c * 66 + tt]); ss += v * v; }
          ss += __shfl_xor(ss, 1); ss += __shfl_xor(ss, 2); ss += __shfl_xor(ss, 4);
          const float r = rsqrtf(ss * (1.f / 512.f) + EPS);
          bf16_t* dst = mix + (size_t)g * D + sub * 64;
#pragma unroll
          for (int q = 0; q < 8; ++q) { float v[8];
#pragma unroll
              for (int j = 0; j < 8; ++j) { const int c = sub * 64 + 8 * q + j; v[j] = bf2f(tl[c * 66 + tt]) * r * p.hy_out_g[c]; }
              u32x4 w; w.x = pk2(v[0], v[1]); w.y = pk2(v[2], v[3]); w.z = pk2(v[4], v[5]); w.w = pk2(v[6], v[7]);
              *(u32x4*)(dst + 8 * q) = w; } }
        { const float lm = fmaxf(l0, fmaxf(l1, l2)); float w0 = __expf(l0 - lm), w1 = __expf(l1 - lm), w2 = __expf(l2 - lm); const float wi = 1.f / (w0 + w1 + w2); w0 *= wi; w1 *= wi; w2 *= wi;
          float ss = 0.f;
#pragma unroll
          for (int q = 0; q < 8; ++q) { const u32x4 a = av[q], b = bv[q], c = cv[q];
#pragma unroll
              for (int j = 0; j < 4; ++j) { const float lo = w0 * bf2f((bf16_t)a[j]) + w1 * bf2f((bf16_t)b[j]) + w2 * bf2f((bf16_t)c[j]);
                  const float hi = w0 * bf2f((bf16_t)(a[j] >> 16)) + w1 * bf2f((bf16_t)(b[j] >> 16)) + w2 * bf2f((bf16_t)(c[j] >> 16)); ss += lo * lo + hi * hi; } }
          ss += __shfl_xor(ss, 1); ss += __shfl_xor(ss, 2); ss += __shfl_xor(ss, 4);
          const float r = rsqrtf(ss * (1.f / 512.f) + EPS);
          bf16_t* dst = mix + (size_t)g * D + 512 + h * 64; const float* ag = p.attn_out_g + h * 64;
#pragma unroll
          for (int q = 0; q < 8; ++q) { const u32x4 a = av[q], b = bv[q], c = cv[q]; u32x4 w;
#pragma unroll
              for (int j = 0; j < 4; ++j) { const float lo = w0 * bf2f((bf16_t)a[j]) + w1 * bf2f((bf16_t)b[j]) + w2 * bf2f((bf16_t)c[j]);
                  const float hi = w0 * bf2f((bf16_t)(a[j] >> 16)) + w1 * bf2f((bf16_t)(b[j] >> 16)) + w2 * bf2f((bf16_t)(c[j] >> 16));
                  w[j] = pk2(lo * r * ag[8 * q + 2 * j], hi * r * ag[8 * q + 2 * j + 1]); }
              *(u32x4*)(dst + 8 * q) = w; } }
    }
}

__device__ __forceinline__ void grid_bar(unsigned* ctr, unsigned target, int wave) {
    __builtin_amdgcn_s_waitcnt(0x0F70);
    __syncthreads();
    if (wave == 0) {
        int l; asm volatile("v_mbcnt_lo_u32_b32 %0, -1, 0\n\tv_mbcnt_hi_u32_b32 %0, -1, %0" : "=v"(l));
        if (l == 0) {
            __builtin_amdgcn_fence(__ATOMIC_RELEASE, "agent");
            __hip_atomic_fetch_add(ctr, 1u, __ATOMIC_RELAXED, __HIP_MEMORY_SCOPE_AGENT);
            while (__hip_atomic_load(ctr, __ATOMIC_RELAXED, __HIP_MEMORY_SCOPE_AGENT) < target) __builtin_amdgcn_s_sleep(2);
            __builtin_amdgcn_fence(__ATOMIC_ACQUIRE, "agent");
        }
    }
    __syncthreads();
}
constexpr int NPH = 13;
__global__ void __launch_bounds__(NTHR, 2) fwd_kernel(Params p) {
    extern __shared__ __attribute__((aligned(16))) unsigned char smem[];
    cg::grid_group grid = cg::this_grid();
    const int lo = p.ph_lo, hi = p.ph_hi;
    const int wave = __builtin_amdgcn_readfirstlane(threadIdx.x >> 6);
    unsigned* barctr = (unsigned*)(p.ws + WS_BAR);
    if (hi - lo > 1) grid.sync();
    unsigned char* ws = p.ws;
    const float* mod = (const float*)(ws + WS_MOD);
    bf16_t* hbuf = (bf16_t*)(ws + WS_RA);
#ifndef REP_MASK
#define REP_MASK 0
#endif
#define PH(k) if (lo <= (k) && (k) < hi) for (int rep_ = 0; rep_ <= ((REP_MASK >> (k)) & 1); ++rep_)
#define SEAM(k) if (lo <= (k) && (k) + 1 < hi) grid_bar(barctr, (unsigned)((k) + 1 - lo) * gridDim.x, wave)
    PH(0) { phase_prep(p, (float*)smem, wave); } SEAM(0);
    PH(1) { phase_hrows(p, p.x_prompt, p.x_sample, p.norm1_g, 0, 1024, hbuf, wave); } SEAM(1);
    PH(2) { pg8::Gemm g{hbuf, (const bf16_t*)(ws + WS_WIN), NTOK, NPROJ, D}; pg8::StaticOrder S; S.init(NTOK, NPROJ, gridDim.x, blockIdx.x);
            EpiProj E{(bf16_t*)(ws + WS_RB), (bf16_t*)(ws + WS_RC)}; pg8::gemm_phase<EpiProj>((LAS unsigned char*)smem, g, S, E, wave); } SEAM(2);
    for (int o = 0; o < 2; ++o) { PH(3 + o) { phase_conv(p, o, smem, wave); } SEAM(3 + o); }
    PH(5) { phase_attn(p, smem, wave); } SEAM(5);
    PH(6) { phase_mixin(p, smem, wave); } SEAM(6);
    PH(7) { pg8::Gemm g{(const bf16_t*)(ws + WS_RC), (const bf16_t*)(ws + WS_WOUT), NTOK, D, D}; pg8::StaticOrder S; S.init(NTOK, D, gridDim.x, blockIdx.x);
            EpiRes E{p.x_prompt, p.x_sample, p.out, mod + 2048}; pg8::gemm_phase<EpiRes>((LAS unsigned char*)smem, g, S, E, wave); } SEAM(7);
    PH(8) { phase_hrows(p, p.out, p.out + (size_t)NPTOK * D, p.norm2_g, 3072, 4096, hbuf, wave); } SEAM(8);
    PH(9) { pg8::Gemm g{hbuf, (const bf16_t*)(ws + WS_WGU), NTOK, 2 * DFF, D}; pg8::StaticOrder S; S.init(NTOK, 2 * DFF, gridDim.x, blockIdx.x);
            EpiGUF E{(bf16_t*)(ws + WS_RB), (float*)(ws + WS_SBP), (float*)(ws + WS_SBU), (float*)(ws + WS_SBG), p.ffn_conv_w, p.ffn_conv_b, (float*)(smem + 131072)}; pg8::gemm_phase<EpiGUF>((LAS unsigned char*)smem, g, S, E, wave); } SEAM(9);
    PH(10) { phase_fix(p, (bf16_t*)(ws + WS_RB), wave); } SEAM(10);
    PH(11) { pg8::Gemm g{(const bf16_t*)(ws + WS_RB), (const bf16_t*)(ws + WS_WD), NTOK, D, DFF}; pg8::StaticOrder S; S.init(NTOK, D, gridDim.x, blockIdx.x);
            EpiRes E{p.out, p.out + (size_t)NPTOK * D, p.out, mod + 5120}; pg8::gemm_phase<EpiRes>((LAS unsigned char*)smem, g, S, E, wave); } SEAM(11);
    PH(12) { phase_final(p, wave); }
#undef PH
#undef SEAM
}

extern "C" void kernel_launch(void* const* d_in, const int* in_sizes, int n_in, void* d_out, int out_size, void* d_ws, size_t ws_size, hipStream_t stream) {
    static int grid = 0;
    if (grid == 0) {
        if (n_in != 28 || ws_size < WS_END) { fprintf(stderr, "kernel_launch: need 28 inputs and %zu bytes of workspace (got %d, %zu)\n", (size_t)WS_END, n_in, ws_size); grid = -1; return; }
        int dev = 0, cus = 0;
        (void)hipGetDevice(&dev); (void)hipDeviceGetAttribute(&cus, hipDeviceAttributeMultiprocessorCount, dev);
        if (hipFuncSetAttribute((const void*)fwd_kernel, hipFuncAttributeMaxDynamicSharedMemorySize, LDS_BYTES) != hipSuccess) { fprintf(stderr, "hipFuncSetAttribute failed\n"); grid = -1; return; }
        int per_cu = 0;
        if (hipOccupancyMaxActiveBlocksPerMultiprocessor(&per_cu, (const void*)fwd_kernel, NTHR, LDS_BYTES) != hipSuccess || per_cu < 1) { fprintf(stderr, "occupancy query: %d\n", per_cu); (void)hipGetLastError(); }
        grid = cus > 0 ? cus : 256;
    }
    if (grid < 0) return;
    (void)hipMemsetAsync((char*)d_ws + WS_NORM, 0, 16384 + 256, stream);
    Params p{};
    const float** pp = (const float**)&p;
    for (int i = 0; i < 28; ++i) pp[i] = (const float*)d_in[i];
    p.out = (float*)d_out; p.ws = (unsigned char*)d_ws; p.ph_lo = 0; p.ph_hi = NPH;
#if defined(MULTI_LAUNCH)
    for (int k = 0; k < NPH; ++k) { p.ph_lo = k; p.ph_hi = k + 1; hipLaunchKernelGGL(fwd_kernel, dim3(grid), dim3(NTHR), LDS_BYTES, stream, p); }
#else
    void* args[] = {&p};
    hipError_t e = hipLaunchCooperativeKernel((const void*)fwd_kernel, dim3(grid), dim3(NTHR), args, LDS_BYTES, stream);
    if (e != hipSuccess) fprintf(stderr, "cooperative launch failed: %s (grid %d)\n", hipGetErrorString(e), grid);
#endif
}
```

```cpp
#include <hip/hip_runtime.h>
#include <hip/hip_cooperative_groups.h>
#include <cstdio>
namespace cg = cooperative_groups;

#define LAS __attribute__((address_space(3)))
typedef unsigned short bf16_t;
typedef short bf16x8 __attribute__((ext_vector_type(8)));
typedef float f32x4 __attribute__((ext_vector_type(4)));
typedef unsigned u32x4 __attribute__((ext_vector_type(4)));
typedef unsigned u32x2 __attribute__((ext_vector_type(2)));
typedef float c2 __attribute__((ext_vector_type(2)));

constexpr int D = 1024, NTOK = 81920, NPTOK = 65536, TP = 2048, TS = 16384, NB = 33;
constexpr int NPROJ = 3072, HYW = 512, DFF = 2816, MODW = 6144;
constexpr int NTHR = 512;
constexpr float EPS = 1e-6f;
constexpr int LDS_BYTES = 139520 + 1024;

constexpr size_t MiB = 1048576;
constexpr size_t WS_NORM = 0;
constexpr size_t WS_BAR  = 16384;
constexpr size_t WS_MOD  = 65536;
constexpr size_t WS_WIN  = 2 * MiB;
constexpr size_t WS_WOUT = 8 * MiB;
constexpr size_t WS_WGU  = 10 * MiB;
constexpr size_t WS_WD   = 21 * MiB;
constexpr size_t WS_RC   = 27 * MiB;
constexpr size_t WS_RB   = WS_RC + 240 * MiB;
constexpr size_t WS_RD   = WS_RB + 240 * MiB;
constexpr size_t WS_RE   = WS_RD + 80 * MiB;
constexpr size_t WS_RG   = WS_RE + 80 * MiB;
constexpr size_t WS_RA   = WS_RG + 144 * MiB;
constexpr size_t WS_END  = WS_RA + 184 * MiB;
constexpr size_t WS_FILTS = WS_RG, WS_FILTP = WS_RG + 128 * MiB;
constexpr size_t WS_ATO2 = WS_RG, WS_LSE = WS_RG + 80 * MiB;
constexpr size_t ATO_STRIDE_01 = 80 * MiB;
constexpr size_t SCR_PER_BLOCK = (15 + 8) * 4096 * 8;

struct Params {
    const float *x_prompt, *x_sample, *c_prompt, *c_sample, *ada_w, *ada_b, *norm1_g, *w_in, *hy_short_w, *hy_short_b,
        *hy_pos_w1, *hy_pos_b1, *hy_sin_freq, *hy_pos_w2, *hy_pos_b2, *hy_pos_w3, *hy_decay, *hy_skip, *hy_out_g,
        *attn_out_g, *w_out, *norm2_g, *ffn_w_gate, *ffn_w_up, *ffn_conv_w, *ffn_conv_b, *ffn_w_down, *final_g;
    float* out; unsigned char* ws;
    int ph_lo, ph_hi;
};

typedef __bf16 bf16v2_t __attribute__((ext_vector_type(2)));
typedef float f32v2_t __attribute__((ext_vector_type(2)));
__device__ __forceinline__ unsigned cvtpk(float lo, float hi) { const f32v2_t v = {lo, hi}; const bf16v2_t b = __builtin_convertvector(v, bf16v2_t); return __builtin_bit_cast(unsigned, b); }
__device__ __forceinline__ unsigned pk2(float lo, float hi) { return cvtpk(lo, hi); }
__device__ __forceinline__ bf16_t f2bf(float f) { return (bf16_t)cvtpk(f, 0.f); }
__device__ __forceinline__ float bf2f(bf16_t b) { return __uint_as_float(((unsigned)b) << 16); }
__device__ __forceinline__ const float* xrow(const Params& p, int g) { return g < NPTOK ? p.x_prompt + (size_t)g * D : p.x_sample + (size_t)(g - NPTOK) * D; }
__device__ __forceinline__ int batch_of(int g) { return g < NPTOK ? (g >> 11) : 32; }
__device__ __forceinline__ int fresh_tid(int wave) {
    int l; asm volatile("v_mbcnt_lo_u32_b32 %0, -1, 0\n\tv_mbcnt_hi_u32_b32 %0, -1, %0" : "=v"(l));
    return (wave << 6) | l; }

namespace pg8 {
constexpr int BM = 256, BK = 64, HALF = 128, HTB = HALF * BK * 2, STAGE_BYTES = 8 * HTB, NXCD = 8, WGM = 8;
__device__ __forceinline__ int lds_byte(int r, int c) { const int st = (r >> 4) * 2 + (c >> 5), rr = r & 15, cc = c & 31, ob = rr * 64 + cc * 2; return st * 1024 + (ob ^ (((ob >> 9) & 1) << 5)); }
__device__ __forceinline__ void stage_rc(int b, int& R, int& C) { const int st = b / 1024, sb = b % 1024, swz = sb ^ (((sb >> 9) & 1) << 5); R = (st >> 1) * 16 + swz / 64; C = (st & 1) * 32 + (swz % 64) / 2; }
__device__ __forceinline__ int perm32(int rho) { const int n = rho >> 4, i = rho & 15; return 8 * (i >> 2) + 4 * n + (i & 3); }
struct Unit { int pm, pn; };
struct Gemm { const bf16_t* A; const bf16_t* Bt; int M, N, K; };
struct StaticOrder {
    int nM, nN, nwg, G, c;
    __device__ void init(int M, int N, int G_, int c_) { nM = M / BM; nN = N / BM; nwg = nM * nN; G = G_; c = c_; }
    __device__ bool next(int i, Unit& u) const {
        const long L = (long)i * G + c; if (L >= nwg) return false;
        int wgid = (int)L; { const int q = nwg / NXCD, r = nwg % NXCD, xcd = wgid % NXCD, off = wgid / NXCD; wgid = (xcd < r ? xcd * (q + 1) : r * (q + 1) + (xcd - r) * q) + off; }
        const int nig = WGM * nN, gid = wgid / nig, fm = gid * WGM, gsz = (nM - fm) < WGM ? (nM - fm) : WGM;
        u.pm = fm + ((wgid % nig) % gsz); u.pn = (wgid % nig) / gsz; return true;
    }
};
template <class Epi>
__device__ __forceinline__ void gemm_phase(LAS unsigned char* lds, const Gemm g, const StaticOrder& S, const Epi& E, int wave) {
    const int tid = fresh_tid(wave), wid = __builtin_amdgcn_readfirstlane(tid >> 6), lane = tid & 63, wr = wid >> 2, wc = wid & 3, fr = lane & 15, fq = lane >> 4;
    const int K = g.K, nt = K / BK;
    unsigned voffA[2], voffB[2];
#pragma unroll
    for (int i = 0; i < 2; ++i) { int R, C; stage_rc(tid * 16 + i * 8192, R, C); const int Rb = Epi::PERM ? ((R & ~31) + perm32(R & 31)) : R;
        voffA[i] = (unsigned)(R * K + C) * 2u; voffB[i] = (unsigned)(Rb * K + C) * 2u; }
    const size_t kstep = (size_t)(BK * 2);
    const size_t hstep = (size_t)HALF * K * 2;
    const size_t tstep = 2 * hstep;
    const unsigned ldsw = (unsigned)wid * 1024u;
    const int aoff = lds_byte(wr * 64 + fr, fq * 8), boff = lds_byte(wc * 32 + fr, fq * 8);
#define PG8_SA(b, h) (((b) * 2 + (h)) * HTB)
#define PG8_SB(b, h) ((4 + (b) * 2 + (h)) * HTB)
#define PG8_STAGE(bufoff, gbase, voff) do { _Pragma("unroll") for (int _i = 0; _i < 2; ++_i) \
        __builtin_amdgcn_global_load_lds((const unsigned*)((const char*)(gbase) + (voff)[_i]), (LAS unsigned*)(lds + (bufoff) + ldsw + _i * 8192), 16, 0, 0); } while (0)
#define PG8_LDA(dst, b, h) do { _Pragma("unroll") for (int m = 0; m < 4; ++m) _Pragma("unroll") for (int k = 0; k < 2; ++k) dst[m][k] = *(const LAS bf16x8*)(lds + PG8_SA(b, h) + aoff + m * 2048 + k * 1024); } while (0)
#define PG8_LDB(dst, b, h) do { _Pragma("unroll") for (int n = 0; n < 2; ++n) _Pragma("unroll") for (int k = 0; k < 2; ++k) dst[n][k] = *(const LAS bf16x8*)(lds + PG8_SB(b, h) + boff + n * 2048 + k * 1024); } while (0)
#define PG8_MMA(ai, bj, At, Bt) do { __builtin_amdgcn_s_setprio(1); _Pragma("unroll") for (int m = 0; m < 4; ++m) _Pragma("unroll") for (int n = 0; n < 2; ++n) _Pragma("unroll") for (int k = 0; k < 2; ++k) \
        acc[ai][bj][m][n] = __builtin_amdgcn_mfma_f32_16x16x32_bf16(Bt[n][k], At[m][k], acc[ai][bj][m][n], 0, 0, 0); __builtin_amdgcn_s_setprio(0); } while (0)
#define PG8_WAIT_V(n) asm volatile("s_waitcnt vmcnt(" #n ")" ::: "memory")
#define PG8_WAIT_L(n) asm volatile("s_waitcnt lgkmcnt(" #n ")" ::: "memory")
#define PG8_BAR __builtin_amdgcn_s_barrier()
#define PG8_SCHED __builtin_amdgcn_sched_barrier(0)
    Unit cur, nxt; int ui = 0;
    if (!S.next(0, cur)) return;
    f32x4 acc[2][2][4][2];
#pragma unroll
    for (int a = 0; a < 2; ++a)
#pragma unroll
        for (int b = 0; b < 2; ++b)
#pragma unroll
            for (int m = 0; m < 4; ++m)
#pragma unroll
                for (int n = 0; n < 2; ++n) acc[a][b][m][n] = (f32x4){0.f, 0.f, 0.f, 0.f};
    bf16x8 At[4][2], B0[2][2], B1[2][2];
    const char* cA = (const char*)g.A + (size_t)cur.pm * tstep; const char* cB = (const char*)g.Bt + (size_t)cur.pn * tstep;
    PG8_STAGE(PG8_SB(0, 0), cB, voffB); PG8_STAGE(PG8_SA(0, 0), cA, voffA); PG8_STAGE(PG8_SB(0, 1), cB + hstep, voffB); PG8_STAGE(PG8_SA(0, 1), cA + hstep, voffA);
    if (wr == 1) PG8_BAR;
    PG8_WAIT_V(4); PG8_BAR;
    PG8_STAGE(PG8_SB(1, 0), cB + kstep, voffB); PG8_STAGE(PG8_SA(1, 0), cA + kstep, voffA); PG8_STAGE(PG8_SB(1, 1), cB + hstep + kstep, voffB);
    PG8_WAIT_V(6); PG8_BAR;
    for (;;) {
        const bool has_next = S.next(ui + 1, nxt);
        const char* nA = has_next ? (const char*)g.A + (size_t)nxt.pm * tstep : cA; const char* nB = has_next ? (const char*)g.Bt + (size_t)nxt.pn * tstep : cB;
        for (int t = 0; t < nt; t += 2) {
            const bool last = (t == nt - 2);
            const char* a1 = cA + (size_t)(t + 1) * kstep;
            const char* a2 = last ? nA : cA + (size_t)(t + 2) * kstep; const char* b2 = last ? nB : cB + (size_t)(t + 2) * kstep;
            const char* a3 = a2 + kstep; const char* b3 = b2 + kstep;
            PG8_LDB(B0, 0, 0); PG8_SCHED; PG8_LDA(At, 0, 0); PG8_STAGE(PG8_SA(1, 1), a1 + hstep, voffA);
            PG8_WAIT_L(8); PG8_BAR; PG8_WAIT_L(0); PG8_MMA(0, 0, At, B0); PG8_BAR; PG8_SCHED;
            PG8_LDB(B1, 0, 1); PG8_STAGE(PG8_SB(0, 0), b2, voffB);
            PG8_BAR; PG8_WAIT_L(0); PG8_MMA(0, 1, At, B1); PG8_BAR;
            PG8_LDA(At, 0, 1); PG8_STAGE(PG8_SA(0, 0), a2, voffA);
            PG8_BAR; PG8_WAIT_L(0); PG8_MMA(1, 0, At, B0); PG8_BAR; PG8_SCHED;
            PG8_STAGE(PG8_SB(0, 1), b2 + hstep, voffB);
            PG8_WAIT_V(6); PG8_BAR; PG8_MMA(1, 1, At, B1); PG8_BAR;
            PG8_LDB(B0, 1, 0); PG8_SCHED; PG8_LDA(At, 1, 0); PG8_STAGE(PG8_SA(0, 1), a2 + hstep, voffA);
            PG8_WAIT_L(8); PG8_BAR; PG8_WAIT_L(0); PG8_MMA(0, 0, At, B0); PG8_BAR; PG8_SCHED;
            PG8_LDB(B1, 1, 1); PG8_STAGE(PG8_SB(1, 0), b3, voffB);
            PG8_BAR; PG8_WAIT_L(0); PG8_MMA(0, 1, At, B1); PG8_BAR;
            PG8_LDA(At, 1, 1); PG8_STAGE(PG8_SA(1, 0), a3, voffA);
            PG8_BAR; PG8_WAIT_L(0); PG8_MMA(1, 0, At, B0); PG8_BAR; PG8_SCHED;
            PG8_STAGE(PG8_SB(1, 1), b3 + hstep, voffB);
            PG8_WAIT_V(6); PG8_BAR; PG8_MMA(1, 1, At, B1); PG8_BAR;
        }
        E(acc, cur, wr, wc, fr, fq);
        if (!has_next) break;
#pragma unroll
        for (int a = 0; a < 2; ++a)
#pragma unroll
            for (int b = 0; b < 2; ++b)
#pragma unroll
                for (int m = 0; m < 4; ++m)
#pragma unroll
                    for (int n = 0; n < 2; ++n) acc[a][b][m][n] = (f32x4){0.f, 0.f, 0.f, 0.f};
        cur = nxt; cA = nA; cB = nB; ++ui;
    }
    PG8_WAIT_V(0);
    if (wr == 0) PG8_BAR;
    PG8_BAR;
#undef PG8_SA
#undef PG8_SB
#undef PG8_STAGE
#undef PG8_LDA
#undef PG8_LDB
#undef PG8_MMA
#undef PG8_WAIT_V
#undef PG8_WAIT_L
#undef PG8_BAR
#undef PG8_SCHED
}
}
using pg8::HALF;

struct EpiProj {
    static constexpr bool PERM = true;
    bf16_t* uhy; bf16_t* qkv;
    __device__ __forceinline__ void operator()(const f32x4 (&acc)[2][2][4][2], const pg8::Unit& u, int wr, int wc, int, int) const {
        int ln_; asm volatile("v_mbcnt_lo_u32_b32 %0, -1, 0\n\tv_mbcnt_hi_u32_b32 %0, -1, %0" : "=v"(ln_)); const int fr = ln_ & 15, fq = ln_ >> 4;
        const int row0 = u.pm * 256 + wr * 64 + fr;
        if (u.pn < 6) {
            bf16_t* cp = uhy + (size_t)(u.pn * 256 + wc * 32 + 8 * fq) * NTOK + row0;
#pragma unroll
            for (int bj = 0; bj < 2; ++bj)
#pragma unroll
                for (int n = 0; n < 2; ++n)
#pragma unroll
                    for (int j = 0; j < 4; ++j) { bf16_t* q = cp + (size_t)(bj * HALF + 4 * n + j) * NTOK;
#pragma unroll
                        for (int ai = 0; ai < 2; ++ai)
#pragma unroll
                            for (int m = 0; m < 4; ++m) q[ai * HALF + m * 16] = f2bf(acc[ai][bj][m][n][j]);
                        asm volatile("" ::: "memory"); }
        } else {
            const int col0 = (u.pn - 6) * 256 + wc * 32 + 8 * fq;
#pragma unroll
            for (int ai = 0; ai < 2; ++ai)
#pragma unroll
                for (int m = 0; m < 4; ++m) { bf16_t* rowp = qkv + (size_t)(row0 + ai * HALF + m * 16) * 1536 + col0;
#pragma unroll
                    for (int bj = 0; bj < 2; ++bj) { const f32x4 v0 = acc[ai][bj][m][0], v1 = acc[ai][bj][m][1];
                        u32x4 w; w.x = pk2(v0[0], v0[1]); w.y = pk2(v0[2], v0[3]); w.z = pk2(v1[0], v1[1]); w.w = pk2(v1[2], v1[3]);
                        *(u32x4*)(rowp + bj * HALF) = w; } }
        }
    }
};
struct EpiRes {
    static constexpr bool PERM = false;
    const float* basep; const float* bases; float* out; const float* gate;
    __device__ __forceinline__ void operator()(const f32x4 (&acc)[2][2][4][2], const pg8::Unit& u, int wr, int wc, int, int) const {
        int ln_; asm volatile("v_mbcnt_lo_u32_b32 %0, -1, 0\n\tv_mbcnt_hi_u32_b32 %0, -1, %0" : "=v"(ln_)); const int fr = ln_ & 15, fq = ln_ >> 4;
        const int row0 = u.pm * 256 + wr * 64 + fr, col0 = u.pn * 256 + wc * 32 + 4 * fq;
        const int bi = batch_of(u.pm * 256);
        const float* base = (u.pm * 256 < NPTOK) ? basep : bases - (size_t)NPTOK * D;
        f32x4 gv[2][2];
#pragma unroll
        for (int bj = 0; bj < 2; ++bj)
#pragma unroll
            for (int n = 0; n < 2; ++n) gv[bj][n] = *(const f32x4*)(gate + (size_t)bi * MODW + col0 + bj * HALF + n * 16);
#pragma unroll
        for (int ai = 0; ai < 2; ++ai) {
            f32x4 bv[4][2][2];
#pragma unroll
            for (int m = 0; m < 4; ++m) { const size_t off = (size_t)(row0 + ai * HALF + m * 16) * D + col0;
#pragma unroll
                for (int bj = 0; bj < 2; ++bj)
#pragma unroll
                    for (int n = 0; n < 2; ++n) bv[m][bj][n] = *(const f32x4*)(base + off + bj * HALF + n * 16); }
#pragma unroll
            for (int m = 0; m < 4; ++m) { const size_t off = (size_t)(row0 + ai * HALF + m * 16) * D + col0;
#pragma unroll
                for (int bj = 0; bj < 2; ++bj)
#pragma unroll
                    for (int n = 0; n < 2; ++n) *(f32x4*)(out + off + bj * HALF + n * 16) = bv[m][bj][n] + gv[bj][n] * acc[ai][bj][m][n]; }
        }
    }
};
__device__ __forceinline__ float gelu_tanh(float x) { const float t = x * x; const float z = x * (2.3022082f + 0.10294324f * t);
    const float e = __builtin_amdgcn_exp2f(z); const float r = __builtin_amdgcn_rcpf(e + 1.f); return x - x * r; }
constexpr int NEDGE = NTOK / 64 * 2;
constexpr size_t WS_SBP = WS_RC, WS_SBU = WS_RC + 32 * MiB, WS_SBG = WS_RC + 64 * MiB;
struct EpiGUF {
    static constexpr bool PERM = true;
    bf16_t* act; float* sbp; float* sbu; float* sbg; const float* cw; const float* cb; float* lw;
    __device__ __forceinline__ void operator()(f32x4 (&acc)[2][2][4][2], const pg8::Unit& u, int wr, int wc, int, int) const {
        int ln_; asm volatile("v_mbcnt_lo_u32_b32 %0, -1, 0\n\tv_mbcnt_hi_u32_b32 %0, -1, %0" : "=v"(ln_)); const int fr = ln_ & 15, fq = ln_ >> 4;
        const int lprev4 = ((ln_ & 48) | ((fr + 15) & 15)) << 2, lnext4 = ((ln_ & 48) | ((fr + 1) & 15)) << 2;
        const int f0 = u.pn * 128 + wc * 32 + 8 * fq;
        float* lwv = lw + (wr * 4 + wc) * 128;
        { const int p0 = ln_ >> 5, col = ln_ & 31, fb = u.pn * 128 + wc * 32;
          const float a_ = cw[p0 * DFF + fb + col]; const float b_ = (p0 == 0) ? cw[2 * DFF + fb + col] : cb[fb + col];
          lwv[p0 * 32 + col] = a_; lwv[(p0 + 2) * 32 + col] = b_; }
        asm volatile("s_waitcnt lgkmcnt(0)" ::: "memory");
#pragma unroll
        for (int ai = 0; ai < 2; ++ai) {
            const int rband = u.pm * 256 + ai * HALF + wr * 64;
#pragma unroll
            for (int n = 0; n < 2; ++n) {
                const bool efirst = (fr == 0), elast = (fr == 15);
                f32x4 eP, eG;
                const size_t eo = (size_t)((rband >> 6) * 2 + (elast ? 1 : 0)) * DFF + f0 + 4 * n;
                if (efirst || elast) { f32x4 eU;
#pragma unroll
                    for (int j = 0; j < 4; ++j) eU[j] = efirst ? acc[ai][1][0][n][j] : acc[ai][1][3][n][j];
                    *(f32x4*)(sbu + eo) = eU; }
#pragma unroll
                for (int j = 0; j < 4; ++j) {
                    const int lc = 8 * fq + 4 * n + j; const float w0 = lwv[lc], w1 = lwv[32 + lc], w2 = lwv[64 + lc], bb = lwv[96 + lc];
                    float gp[4], gn[4];
#pragma unroll
                    for (int m = 0; m < 4; ++m) { const int gi_ = __float_as_int(acc[ai][0][m][n][j]); gp[m] = __int_as_float(__builtin_amdgcn_ds_bpermute(lprev4, gi_)); gn[m] = __int_as_float(__builtin_amdgcn_ds_bpermute(lnext4, gi_)); }
                    float pre0 = 0.f, pre3 = 0.f;
#pragma unroll
                    for (int m = 0; m < 4; ++m) {
                        const float g = acc[ai][0][m][n][j], uv = acc[ai][1][m][n][j];
                        const float pv = (fr == 0) ? (m > 0 ? gp[m > 0 ? m - 1 : 0] : 0.f) : gp[m];
                        const float nv = (fr == 15) ? (m < 3 ? gn[m < 3 ? m + 1 : 3] : 0.f) : gn[m];
                        const float pre = w0 * pv + w1 * g + w2 * nv + bb;
                        if (m == 0) pre0 = pre;
                        if (m == 3) pre3 = pre;
                        acc[ai][1][m][n][j] = gelu_tanh(pre) * uv;
                    }
                    eP[j] = efirst ? pre0 : pre3;
                    __builtin_amdgcn_sched_barrier(0);
                }
#pragma unroll
                for (int j = 0; j < 4; ++j) eG[j] = efirst ? acc[ai][0][0][n][j] : acc[ai][0][3][n][j];
                if (efirst || elast) { *(f32x4*)(sbp + eo) = eP; *(f32x4*)(sbg + eo) = eG; }
            }
#pragma unroll
            for (int m = 0; m < 4; ++m) { bf16_t* rowp = act + (size_t)(rband + m * 16 + fr) * DFF + f0;
                const f32x4 v0 = acc[ai][1][m][0], v1 = acc[ai][1][m][1];
                u32x4 w; w.x = pk2(v0[0], v0[1]); w.y = pk2(v0[2], v0[3]); w.z = pk2(v1[0], v1[1]); w.w = pk2(v1[2], v1[3]);
                *(u32x4*)rowp = w; }
        }
    }
};
__device__ void transpose_tile(const float* src, bf16_t* dst, int K, int N, int k0, int n0, int drow0, float* tile  , int wave) {
    const int tid = fresh_tid(wave);
    __syncthreads();
#pragma unroll
    for (int i = 0; i < 2; ++i) { const int kk = (tid >> 4) + 32 * i, n4 = (tid & 15) * 4;
        const f32x4 v = *(const f32x4*)(src + (size_t)(k0 + kk) * N + n0 + n4);
        tile[kk * 65 + n4 + 0] = v[0]; tile[kk * 65 + n4 + 1] = v[1]; tile[kk * 65 + n4 + 2] = v[2]; tile[kk * 65 + n4 + 3] = v[3]; }
    __syncthreads();
    const int nn = tid >> 3, k8 = (tid & 7) * 8;
    u32x4 w; w.x = pk2(tile[(k8 + 0) * 65 + nn], tile[(k8 + 1) * 65 + nn]); w.y = pk2(tile[(k8 + 2) * 65 + nn], tile[(k8 + 3) * 65 + nn]);
    w.z = pk2(tile[(k8 + 4) * 65 + nn], tile[(k8 + 5) * 65 + nn]); w.w = pk2(tile[(k8 + 6) * 65 + nn], tile[(k8 + 7) * 65 + nn]);
    *(u32x4*)(dst + (size_t)(drow0 + nn) * K + k0 + k8) = w;
}
__device__ void mod_item(const Params& p, int item, float* lds, int wave) {
    const int tid = fresh_tid(wave), col = tid & 63, kg = tid >> 6, col0 = item * 64;
    float* mod = (float*)(p.ws + WS_MOD);
    float acc[NB];
#pragma unroll
    for (int b = 0; b < NB; ++b) acc[b] = 0.f;
    for (int half = 0; half < 2; ++half) {
        __syncthreads();
        for (int e = tid; e < NB * 512; e += NTHR) { const int b = e >> 9, kk = e & 511;
            const float c = b < 32 ? p.c_prompt[b * D + half * 512 + kk] : p.c_sample[half * 512 + kk];
            lds[kk * 36 + b] = c / (1.f + __expf(-c)); }
        __syncthreads();
        for (int kk = kg * 64; kk < kg * 64 + 64; ++kk) {
            const float w = p.ada_w[(size_t)(half * 512 + kk) * MODW + col0 + col];
#pragma unroll
            for (int b = 0; b < NB; ++b) acc[b] += lds[kk * 36 + b] * w;
        }
    }
    __syncthreads();
#pragma unroll
    for (int b = 0; b < NB; ++b) lds[(kg * NB + b) * 64 + col] = acc[b];
    __syncthreads();
    for (int e = tid; e < NB * 64; e += NTHR) { const int b = e >> 6, cc = e & 63; float s = 0.f;
#pragma unroll
        for (int k = 0; k < 8; ++k) s += lds[(k * NB + b) * 64 + cc];
        mod[b * MODW + col0 + cc] = s + p.ada_b[col0 + cc]; }
}
__device__ __forceinline__ void filt_item(const Params& p, int lsel, int tile, float* lds, int wave, float (&colsum)[16], bool flush) {
    const int tid = fresh_tid(wave);
    const int L = lsel ? TS : TP; const int t0 = tile * 16;
    float* filt = (float*)(p.ws + (lsel ? WS_FILTS : WS_FILTP));
    float* normsum = (float*)(p.ws + WS_NORM) + lsel * 2048;
    float* feat = lds;
    float* h1 = lds + 16 * 36;
    float* h2 = h1 + 16 * 64;
    __syncthreads();
    if (tid < 16 * 17) { const int t = tid / 17, j = tid % 17; const int tt = t0 + t;
        if (j == 16) feat[t * 36] = (float)tt / (float)(L - 1);
        else { const float band = 1e-4f + (float)j * ((15.0f - 1e-4f) / 15.0f);
            double turns = (double)tt * (double)band / (double)L; turns -= floor(turns);
            float s, c; sincospif((float)(2.0 * turns), &s, &c);
            feat[t * 36 + 1 + j] = c; feat[t * 36 + 17 + j] = s; } }
    __syncthreads();
    for (int e = tid; e < 1024; e += NTHR) { const int t = e >> 6, k = e & 63; float a = p.hy_pos_b1[k];
        for (int f = 0; f < 33; ++f) a += feat[t * 36 + f] * p.hy_pos_w1[f * 64 + k];
        h1[t * 64 + k] = sinf(p.hy_sin_freq[k] * a); }
    __syncthreads();
    for (int e = tid; e < 1024; e += NTHR) { const int t = e >> 6, k = e & 63; float a = p.hy_pos_b2[k];
        for (int j = 0; j < 64; ++j) a += h1[t * 64 + j] * p.hy_pos_w2[j * 64 + k];
        h2[t * 64 + k] = sinf(p.hy_sin_freq[64 + k] * a); }
    __syncthreads();
    {
        const int lane = tid & 63, l15 = lane & 15, g = lane >> 4, wv = tid >> 6;
        float av[16];
#pragma unroll
        for (int s_ = 0; s_ < 16; ++s_) av[s_] = h2[l15 * 64 + 4 * s_ + g];
        const float inv_lm1 = 1.f / (float)(L - 1);
#pragma unroll
        for (int ct = 0; ct < 16; ++ct) {
            const int col = wv * 256 + ct * 16 + l15;
            const float* wp = p.hy_pos_w3 + (size_t)g * 2048 + col;
            f32x4 acc = (f32x4){0.f, 0.f, 0.f, 0.f};
#pragma unroll
            for (int s_ = 0; s_ < 16; ++s_) acc = __builtin_amdgcn_mfma_f32_16x16x4f32(av[s_], wp[(size_t)s_ * 4 * 2048], acc, 0, 0, 0);
            const float dec = fabsf(p.hy_decay[col]); float asum = 0.f;
#pragma unroll
            for (int r = 0; r < 4; ++r) { const float tn = (float)(t0 + 4 * g + r) * inv_lm1; acc[r] *= __expf(-tn * dec); asum += fabsf(acc[r]); }
            *(f32x4*)(filt + (size_t)col * L + t0 + 4 * g) = acc;
            colsum[ct] += asum;
            if (flush) { float tot = colsum[ct]; tot += __shfl_xor(tot, 16); tot += __shfl_xor(tot, 32); if (g == 0) atomicAdd(normsum + col, tot); colsum[ct] = 0.f; }
        }
    }
}
constexpr int N_FILT_ITEMS = TP / 16 + TS / 16;
constexpr int N_MOD_ITEMS = MODW / 64;
constexpr int NT_WIN = 16 * 48, NT_WOUT = 16 * 16, NT_G = 16 * 44, NT_D = 44 * 16;
constexpr int N_TR_ITEMS = NT_WIN + NT_WOUT + 2 * NT_G + NT_D;
__device__ void phase_prep(const Params& p, float* lds, int wave) {
    const int total = N_FILT_ITEMS + N_MOD_ITEMS + N_TR_ITEMS;
    float colsum[16];
#pragma unroll
    for (int i = 0; i < 16; ++i) colsum[i] = 0.f;
    for (int it = blockIdx.x; it < total; it += gridDim.x) {
        if (it < N_FILT_ITEMS) { const bool longf = it < TS / 16; const int nx = it + gridDim.x;
            const bool flush = !(nx < N_FILT_ITEMS && ((nx < TS / 16) == longf));
            filt_item(p, longf ? 1 : 0, longf ? it : it - TS / 16, lds, wave, colsum, flush); }
        else if (it < N_FILT_ITEMS + N_MOD_ITEMS) mod_item(p, it - N_FILT_ITEMS, lds, wave);
        else { int q = it - N_FILT_ITEMS - N_MOD_ITEMS;
            if (q < NT_WIN) transpose_tile(p.w_in, (bf16_t*)(p.ws + WS_WIN), 1024, 3072, (q / 48) * 64, (q % 48) * 64, (q % 48) * 64, lds, wave);
            else if ((q -= NT_WIN) < NT_WOUT) transpose_tile(p.w_out, (bf16_t*)(p.ws + WS_WOUT), 1024, 1024, (q / 16) * 64, (q % 16) * 64, (q % 16) * 64, lds, wave);
            else if ((q -= NT_WOUT) < NT_G) { const int n0 = (q % 44) * 64; transpose_tile(p.ffn_w_gate, (bf16_t*)(p.ws + WS_WGU), 1024, DFF, (q / 44) * 64, n0, (n0 >> 7) * 256 + (n0 & 127), lds, wave); }
            else if ((q -= NT_G) < NT_G) { const int n0 = (q % 44) * 64; transpose_tile(p.ffn_w_up, (bf16_t*)(p.ws + WS_WGU), 1024, DFF, (q / 44) * 64, n0, (n0 >> 7) * 256 + 128 + (n0 & 127), lds, wave); }
            else { q -= NT_G; transpose_tile(p.ffn_w_down, (bf16_t*)(p.ws + WS_WD), DFF, 1024, (q / 16) * 64, (q % 16) * 64, (q % 16) * 64, lds, wave); }
        }
    }
}

__device__ void phase_hrows(const Params& p, const float* srcp, const float* srcs, const float* gamma, int sh_off, int sc_off, bf16_t* h, int wave) {
    const int tid = fresh_tid(wave); const int lane = tid & 63, wv = tid >> 6;
    const float* mod = (const float*)(p.ws + WS_MOD);
    const int stride = gridDim.x * 8;
    for (int g0 = blockIdx.x * 8 + wv; g0 < NTOK; g0 += 2 * stride) {
        f32x4 v[2][4]; float ss[2];
#pragma unroll
        for (int u = 0; u < 2; ++u) { const int g = g0 + u * stride; ss[u] = 0.f;
            if (g < NTOK) { const float* x = g < NPTOK ? srcp + (size_t)g * D : srcs + (size_t)(g - NPTOK) * D;
#pragma unroll
                for (int i = 0; i < 4; ++i) v[u][i] = *(const f32x4*)(x + lane * 8 + 512 * (i >> 1) + 4 * (i & 1)); } }
#pragma unroll
        for (int u = 0; u < 2; ++u) { const int g = g0 + u * stride;
            if (g < NTOK) {
#pragma unroll
                for (int i = 0; i < 4; ++i) ss[u] += v[u][i][0] * v[u][i][0] + v[u][i][1] * v[u][i][1] + v[u][i][2] * v[u][i][2] + v[u][i][3] * v[u][i][3];
#pragma unroll
                for (int o = 32; o >= 1; o >>= 1) ss[u] += __shfl_xor(ss[u], o);
                const float r = rsqrtf(ss[u] * (1.f / D) + EPS); const int b = batch_of(g);
#pragma unroll
                for (int i2 = 0; i2 < 2; ++i2) { const int c = lane * 8 + 512 * i2; u32x4 w;
#pragma unroll
                    for (int hf = 0; hf < 2; ++hf) { const int cc = c + 4 * hf;
                        const f32x4 gm = *(const f32x4*)(gamma + cc), sc = *(const f32x4*)(mod + b * MODW + sc_off + cc), sh = *(const f32x4*)(mod + b * MODW + sh_off + cc);
                        const f32x4 y = v[u][2 * i2 + hf] * r * gm * (sc + 1.f) + sh;
                        w[2 * hf] = pk2(y[0], y[1]); w[2 * hf + 1] = pk2(y[2], y[3]); }
                    *(u32x4*)(h + (size_t)g * D + c) = w; } } }
    }
}
__device__ void phase_final(const Params& p, int wave) {
    const int tid = fresh_tid(wave); const int lane = tid & 63, wv = tid >> 6;
    const int stride = gridDim.x * 8;
    for (int g0 = blockIdx.x * 8 + wv; g0 < NTOK; g0 += 2 * stride) {
        f32x4 v[2][4]; float ss[2];
#pragma unroll
        for (int u = 0; u < 2; ++u) { const int g = g0 + u * stride; ss[u] = 0.f;
            if (g < NTOK) { const float* x = p.out + (size_t)g * D;
#pragma unroll
                for (int i = 0; i < 4; ++i) v[u][i] = *(const f32x4*)(x + lane * 4 + 256 * i); } }
#pragma unroll
        for (int u = 0; u < 2; ++u) { const int g = g0 + u * stride;
            if (g < NTOK) { float* x = p.out + (size_t)g * D;
#pragma unroll
                for (int i = 0; i < 4; ++i) ss[u] += v[u][i][0] * v[u][i][0] + v[u][i][1] * v[u][i][1] + v[u][i][2] * v[u][i][2] + v[u][i][3] * v[u][i][3];
#pragma unroll
                for (int o = 32; o >= 1; o >>= 1) ss[u] += __shfl_xor(ss[u], o);
                const float r = rsqrtf(ss[u] * (1.f / D) + EPS);
#pragma unroll
                for (int i = 0; i < 4; ++i) { const int c = lane * 4 + 256 * i; *(f32x4*)(x + c) = v[u][i] * r * *(const f32x4*)(p.final_g + c); } } }
    }
}
__device__ void phase_fix(const Params& p, bf16_t* act, int wave) {
    const int tid = fresh_tid(wave);
    const float* sbp = (const float*)(p.ws + WS_SBP); const float* sbu = (const float*)(p.ws + WS_SBU); const float* sbg = (const float*)(p.ws + WS_SBG);
    constexpr int per_row = DFF / 4;
    for (int e = blockIdx.x * NTHR + tid; e < NEDGE * per_row; e += gridDim.x * NTHR) {
        const int idx = e / per_row, f = (e % per_row) * 4;
        const int r = (idx >> 1) * 64 + ((idx & 1) ? 63 : 0);
        const int t = r < NPTOK ? (r & (TP - 1)) : r - NPTOK; const int T = r < NPTOK ? TP : TS;
        f32x4 pre = *(const f32x4*)(sbp + (size_t)idx * DFF + f);
        const f32x4 uu = *(const f32x4*)(sbu + (size_t)idx * DFF + f);
        if (!(idx & 1)) { if (t > 0) pre += *(const f32x4*)(p.ffn_conv_w + f) * *(const f32x4*)(sbg + (size_t)(idx - 1) * DFF + f); }
        else { if (t < T - 1) pre += *(const f32x4*)(p.ffn_conv_w + 2 * DFF + f) * *(const f32x4*)(sbg + (size_t)(idx + 1) * DFF + f); }
        u32x2 w; w.x = pk2(gelu_tanh(pre[0]) * uu[0], gelu_tanh(pre[1]) * uu[1]); w.y = pk2(gelu_tanh(pre[2]) * uu[2], gelu_tanh(pre[3]) * uu[3]);
        *(u32x2*)(act + (size_t)r * DFF + f) = w;
    }
}

#define LP(i) ((i) + ((i) >> 3))
__device__ __forceinline__ c2 cmul(c2 a, c2 b) { return (c2){a.x * b.x - a.y * b.y, a.x * b.y + a.y * b.x}; }
__device__ __forceinline__ c2 cmulc(c2 a, c2 b) { return (c2){a.x * b.x + a.y * b.y, a.y * b.x - a.x * b.y}; }
__device__ __forceinline__ c2 mni(c2 a) { return (c2){a.y, -a.x}; }
__device__ __forceinline__ void dft8(c2 (&x)[8]) {
    const float s = 0.70710678118654752f;
    const c2 a0 = x[0] + x[4], a4 = x[0] - x[4], a1 = x[1] + x[5], a5 = x[1] - x[5], a2 = x[2] + x[6], a6 = x[2] - x[6], a3 = x[3] + x[7], a7 = x[3] - x[7];
    const c2 a5w = (c2){(a5.x + a5.y) * s, (a5.y - a5.x) * s};
    const c2 a6w = mni(a6);
    const c2 a7w = (c2){(a7.y - a7.x) * s, -(a7.x + a7.y) * s};
    const c2 b0 = a0 + a2, b1 = a0 - a2, b2 = a1 + a3, b3 = mni(a1 - a3);
    x[0] = b0 + b2; x[4] = b0 - b2; x[2] = b1 + b3; x[6] = b1 - b3;
    const c2 c0 = a4 + a6w, c1 = a4 - a6w, c2_ = a5w + a7w, c3 = mni(a5w - a7w);
    x[1] = c0 + c2_; x[5] = c0 - c2_; x[3] = c1 + c3; x[7] = c1 - c3;
}
__device__ __forceinline__ c2 mpi(c2 a) { return (c2){-a.y, a.x}; }
__device__ __forceinline__ void idft8(c2 (&x)[8]) {
    const float s = 0.70710678118654752f;
    const c2 a0 = x[0] + x[4], a4 = x[0] - x[4], a1 = x[1] + x[5], a5 = x[1] - x[5], a2 = x[2] + x[6], a6 = x[2] - x[6], a3 = x[3] + x[7], a7 = x[3] - x[7];
    const c2 a5w = (c2){(a5.x - a5.y) * s, (a5.x + a5.y) * s};
    const c2 a6w = mpi(a6);
    const c2 a7w = (c2){-(a7.x + a7.y) * s, (a7.x - a7.y) * s};
    const c2 b0 = a0 + a2, b1 = a0 - a2, b2 = a1 + a3, b3 = mpi(a1 - a3);
    x[0] = b0 + b2; x[4] = b0 - b2; x[2] = b1 + b3; x[6] = b1 - b3;
    const c2 c0 = a4 + a6w, c1 = a4 - a6w, c2_ = a5w + a7w, c3 = mpi(a5w - a7w);
    x[1] = c0 + c2_; x[5] = c0 - c2_; x[3] = c1 + c3; x[7] = c1 - c3;
}
__device__ __forceinline__ void fwd_s0(c2 (&x)[8], c2* buf, const c2* tws, int tid) {
    dft8(x);
#pragma unroll
    for (int q = 1; q < 8; ++q) x[q] = cmul(x[q], tws[(q - 1) * 512 + tid]);
    { c2* bp_ = buf + LP(tid);
#pragma unroll
    for (int q = 0; q < 8; ++q) bp_[576 * q] = x[q]; }
}
template <int S> __device__ __forceinline__ void fwd_mid(c2* buf, const c2* tws, int tid) {
    constexpr int lq = 9 - 3 * S, Q = 1 << lq; const c2* T = tws + (S == 1 ? 3584 : 4032);
    const int k = tid & (Q - 1), base = ((tid >> lq) << (lq + 3)) + k;
    c2 x[8];
    c2* bp_ = buf + LP(base); constexpr int QP = Q + Q / 8;
#pragma unroll
    for (int r = 0; r < 8; ++r) x[r] = bp_[r * QP];
    dft8(x);
#pragma unroll
    for (int q = 1; q < 8; ++q) x[q] = cmul(x[q], T[(q - 1) * Q + k]);
#pragma unroll
    for (int q = 0; q < 8; ++q) bp_[q * QP] = x[q];
}
__device__ __forceinline__ void fwd_s3(c2 (&x)[8], const c2* buf, int tid) {
#pragma unroll
    for (int r = 0; r < 8; ++r) x[r] = buf[9 * tid + r];
    dft8(x);
}
__device__ __forceinline__ void inv_s3(c2 (&x)[8], c2* buf, int tid) {
    idft8(x);
#pragma unroll
    for (int q = 0; q < 8; ++q) buf[9 * tid + q] = x[q];
}
template <int S> __device__ __forceinline__ void inv_mid(c2* buf, const c2* tws, int tid) {
    constexpr int lq = 9 - 3 * S, Q = 1 << lq; const c2* T = tws + (S == 1 ? 3584 : 4032);
    const int k = tid & (Q - 1), base = ((tid >> lq) << (lq + 3)) + k;
    c2 x[8];
    c2* bp_ = buf + LP(base); constexpr int QP = Q + Q / 8;
#pragma unroll
    for (int r = 0; r < 8; ++r) { c2 v = bp_[r * QP]; if (r) v = cmulc(v, T[(r - 1) * Q + k]); x[r] = v; }
    idft8(x);
#pragma unroll
    for (int q = 0; q < 8; ++q) bp_[q * QP] = x[q];
}
__device__ __forceinline__ void inv_s0(c2 (&x)[8], const c2* buf, const c2* tws, int tid) {
    const c2* bp_ = buf + LP(tid);
#pragma unroll
    for (int r = 0; r < 8; ++r) { c2 v = bp_[576 * r]; if (r) v = cmulc(v, tws[(r - 1) * 512 + tid]); x[r] = v; }
    idft8(x);
}
__device__ __forceinline__ void fft_fwd_regs2(c2 (&x0)[8], c2 (&x1)[8], c2* buf0, c2* buf1, const c2* tws, int tid) {
    fwd_s0(x0, buf0, tws, tid); fwd_s0(x1, buf1, tws, tid); __syncthreads();
    fwd_mid<1>(buf0, tws, tid); fwd_mid<1>(buf1, tws, tid); __syncthreads();
    fwd_mid<2>(buf0, tws, tid); fwd_mid<2>(buf1, tws, tid); __syncthreads();
    fwd_s3(x0, buf0, tid); fwd_s3(x1, buf1, tid);
}
__device__ __forceinline__ void fft_inv_regs2(c2 (&x0)[8], c2 (&x1)[8], c2* buf0, c2* buf1, const c2* tws, int tid) {
    inv_s3(x0, buf0, tid); inv_s3(x1, buf1, tid); __syncthreads();
    inv_mid<2>(buf0, tws, tid); inv_mid<2>(buf1, tws, tid); __syncthreads();
    inv_mid<1>(buf0, tws, tid); inv_mid<1>(buf1, tws, tid); __syncthreads();
    inv_s0(x0, buf0, tws, tid); inv_s0(x1, buf1, tws, tid);
}
__device__ __forceinline__ float subfilt(const float* hf, const float* hb, int L, int d, int m) {
    if (m == 2048) return 0.f;
    const int l = 2048 * d + (m < 2048 ? m : m - 4096);
    if (l >= 0) return l < L ? hf[l] : 0.f;
    return -l < L ? hb[-l] : 0.f;
}
constexpr int RAWROW = 2064;
struct QuadRegs { u32x4 v[4]; unsigned h[4]; };
__device__ __forceinline__ QuadRegs quad_load(const bf16_t* zsrc, const bf16_t* gsrc, int gstart, bool joined, bool first, bool last, int tid) {
    const bf16_t* src = ((tid >> 8) ? gsrc : zsrc) + gstart; const int ci = tid & 255;
    QuadRegs R;
#pragma unroll
    for (int k = 0; k < 4; ++k) { R.v[k] = *(const u32x4*)(src + 2048 * k + 8 * ci); R.h[k] = 0u; }
    if (joined) {
        if (ci == 0) {
#pragma unroll
            for (int k = 0; k < 4; ++k) if (k > 0 || !first) R.h[k] = src[2048 * k - 1]; }
        if (ci == 255) {
#pragma unroll
            for (int k = 0; k < 4; ++k) if (k < 3 || !last) R.h[k] = src[2048 * (k + 1)]; }
    }
    return R;
}
__device__ __forceinline__ void quad_store(const QuadRegs& R, bf16_t* raw  , int tid) {
    bf16_t* base = raw + (tid >> 8) * 4 * RAWROW; const int ci = tid & 255;
#pragma unroll
    for (int k = 0; k < 4; ++k) { *(u32x4*)(base + k * RAWROW + 8 + 8 * ci) = R.v[k];
        if (ci == 0) base[k * RAWROW + 7] = (bf16_t)R.h[k];
        if (ci == 255) base[k * RAWROW + 2056] = (bf16_t)R.h[k]; }
}
__device__ __forceinline__ float dwl(const bf16_t* r, int t, float w0, float w1, float w2, float b) { return w0 * bf2f(r[7 + t]) + w1 * bf2f(r[8 + t]) + w2 * bf2f(r[9 + t]) + b; }
__device__ __forceinline__ void phase_conv(const Params& p, int o, unsigned char* smem, int wave) {
    const int tid = fresh_tid(wave);
    c2* buf0 = (c2*)smem;
    c2* buf1 = (c2*)(smem + 36864);
    c2* tws = (c2*)(smem + 73728);
    bf16_t* raw = (bf16_t*)(smem + 106496);
    const bf16_t* uhy = (const bf16_t*)(p.ws + WS_RB);
    const bf16_t* z1 = (const bf16_t*)(p.ws + WS_RD);
    bf16_t* outp = (bf16_t*)(p.ws + (o == 0 ? WS_RD : WS_RE));
    c2* scr = (c2*)(p.ws + WS_RA + (size_t)blockIdx.x * SCR_PER_BLOCK);
    const float* normsum = (const float*)(p.ws + WS_NORM);
    __syncthreads();
    for (int n = tid; n < 4088; n += NTHR) { int e;
        if (n < 3584) e = ((n >> 9) + 1) * (n & 511); else if (n < 4032) e = (((n - 3584) >> 6) + 1) * ((n - 3584) & 63) * 8; else e = (((n - 4032) >> 3) + 1) * ((n - 4032) & 7) * 64;
        float s, c; sincospif((float)e * (1.f / 2048.f), &s, &c); tws[n] = (c2){c, -s}; }
    __syncthreads();
    const bool g256 = gridDim.x == 256;
    const int nrounds = g256 ? 4 : (1024 + gridDim.x - 1) / gridDim.x;
#pragma unroll 1
    for (int rd = 0; rd < nrounds; ++rd) {
        bool samp; int c;
        if (g256) { samp = ((blockIdx.x + rd) & 1) == 0; c = (rd >> 1) * 256 + blockIdx.x; }
        else { const int it = blockIdx.x + rd * gridDim.x; if (it >= 1024) break; samp = it < 512; c = it & 511; }
        const int lsel = samp ? 1 : 0; const int L = samp ? TS : TP;
        const float* filt = (const float*)(p.ws + (samp ? WS_FILTS : WS_FILTP));
        const float* hf = filt + (size_t)((o * 2 + 0) * 512 + c) * L; const float* hb = filt + (size_t)((o * 2 + 1) * 512 + c) * L;
        const float nrm = normsum[lsel * 2048 + (o * 2) * 512 + c] + normsum[lsel * 2048 + (o * 2 + 1) * 512 + c];
        const float scale = 1.f / (4096.f * nrm);
        const float skip = p.hy_skip[o * 512 + c];
        const int zc = c, gc = (o == 0 ? 512 : 1024) + c;
        const float zw0 = p.hy_short_w[zc], zw1 = p.hy_short_w[1536 + zc], zw2 = p.hy_short_w[3072 + zc], zb = p.hy_short_b[zc];
        const float gw0 = p.hy_short_w[gc], gw1 = p.hy_short_w[1536 + gc], gw2 = p.hy_short_w[3072 + gc], gb = p.hy_short_b[gc];
        const bf16_t* grow = uhy + (size_t)gc * NTOK;
        const bf16_t* zrow = (o == 0) ? uhy + (size_t)zc * NTOK : z1 + (size_t)c * NTOK;
        bf16_t* orow = outp + (size_t)c * NTOK;
        const bf16_t* rg = raw + 4 * RAWROW;
#define ZVAL(r, t) ((o == 0) ? dwl((r), (t), zw0, zw1, zw2, zb) : bf2f((r)[8 + (t)]))
#define EPI(XV, k0, gq) do { _Pragma("unroll") for (int q = 0; q < 4; ++q) { const int t = tid + 512 * q; const c2 y = (XV)[q] * scale; \
            const float za_ = ZVAL(raw + (k0) * RAWROW, t), zb_ = ZVAL(raw + ((k0) + 1) * RAWROW, t); \
            const float ga_ = dwl(rg + (k0) * RAWROW, t, gw0, gw1, gw2, gb), gb_ = dwl(rg + ((k0) + 1) * RAWROW, t, gw0, gw1, gw2, gb); \
            orow[(gq) + (k0) * 2048 + t] = f2bf(ga_ * (y.x + skip * za_)); orow[(gq) + ((k0) + 1) * 2048 + t] = f2bf(gb_ * (y.y + skip * zb_)); } } while (0)
#define EPIZ(XV, ZK, k0, gq) do { _Pragma("unroll") for (int q = 0; q < 4; ++q) { const int t = tid + 512 * q; const c2 y = (XV)[q] * scale; \
            const float ga_ = dwl(rg + (k0) * RAWROW, t, gw0, gw1, gw2, gb), gb_ = dwl(rg + ((k0) + 1) * RAWROW, t, gw0, gw1, gw2, gb); \
            orow[(gq) + (k0) * 2048 + t] = f2bf(ga_ * (y.x + skip * (ZK)[q].x)); orow[(gq) + ((k0) + 1) * 2048 + t] = f2bf(gb_ * (y.y + skip * (ZK)[q].y)); } } while (0)
        if (!samp) {
            c2 K[8], dmy[8];
#pragma unroll
            for (int r = 0; r < 8; ++r) { K[r] = (c2){subfilt(hf, hb, L, 0, tid + 512 * r), 0.f}; dmy[r] = (c2){0.f, 0.f}; }
            __syncthreads();
            fft_fwd_regs2(K, dmy, buf0, buf1, tws, tid);
            QuadRegs R = quad_load(zrow, grow, 0, false, true, true, tid);
#pragma unroll 1
            for (int i = 0; i < 8; ++i) {
                const int gq = i * 8192;
                __syncthreads();
                quad_store(R, raw, tid);
                __syncthreads();
                if (i < 7) R = quad_load(zrow, grow, gq + 8192, false, true, true, tid);
                c2 x0[8], x1[8], zk0[4], zk1[4];
#pragma unroll
                for (int r = 0; r < 4; ++r) { const int t = tid + 512 * r;
                    x0[r] = (c2){ZVAL(raw, t), ZVAL(raw + RAWROW, t)}; x1[r] = (c2){ZVAL(raw + 2 * RAWROW, t), ZVAL(raw + 3 * RAWROW, t)}; zk0[r] = x0[r]; zk1[r] = x1[r];
                    x0[4 + r] = (c2){0.f, 0.f}; x1[4 + r] = (c2){0.f, 0.f}; }
                fft_fwd_regs2(x0, x1, buf0, buf1, tws, tid);
#pragma unroll
                for (int q = 0; q < 8; ++q) { x0[q] = cmul(x0[q], K[q]); x1[q] = cmul(x1[q], K[q]); }
                fft_inv_regs2(x0, x1, buf0, buf1, tws, tid);
                EPIZ(x0, zk0, 0, gq); EPIZ(x1, zk1, 2, gq);
            }
        } else {
            c2* sK = scr; c2* sZ = scr + 15 * 4096;
            const int gs = NPTOK;
#pragma unroll 1
            for (int d = -7; d <= 7; d += 2) {
                c2 x0[8], x1[8];
#pragma unroll
                for (int r = 0; r < 8; ++r) { x0[r] = (c2){subfilt(hf, hb, L, d, tid + 512 * r), 0.f}; x1[r] = (c2){d < 7 ? subfilt(hf, hb, L, d + 1, tid + 512 * r) : 0.f, 0.f}; }
                __syncthreads();
                fft_fwd_regs2(x0, x1, buf0, buf1, tws, tid);
#pragma unroll
                for (int q = 0; q < 8; ++q) { sK[((d + 7) * 8 + q) * 512 + tid] = x0[q]; if (d < 7) sK[((d + 8) * 8 + q) * 512 + tid] = x1[q]; }
            }
            {
                QuadRegs R = quad_load(zrow, grow, gs, true, true, false, tid);
#pragma unroll 1
                for (int a = 0; a < 2; ++a) {
                    __syncthreads();
                    quad_store(R, raw, tid);
                    __syncthreads();
                    if (a < 1) R = quad_load(zrow, grow, gs + 8192, true, false, true, tid);
#pragma unroll 1
                    for (int hh = 0; hh < 2; ++hh) {
                        c2 x0[8], x1[8];
#pragma unroll
                        for (int r = 0; r < 4; ++r) { const int t = tid + 512 * r; x0[r] = (c2){ZVAL(raw + (2 * hh) * RAWROW, t), 0.f}; x1[r] = (c2){ZVAL(raw + (2 * hh + 1) * RAWROW, t), 0.f}; x0[4 + r] = (c2){0.f, 0.f}; x1[4 + r] = (c2){0.f, 0.f}; }
                        fft_fwd_regs2(x0, x1, buf0, buf1, tws, tid);
#pragma unroll
                        for (int q = 0; q < 8; ++q) { sZ[((4 * a + 2 * hh) * 8 + q) * 512 + tid] = x0[q]; sZ[((4 * a + 2 * hh + 1) * 8 + q) * 512 + tid] = x1[q]; }
                        __syncthreads();
                    }
                }
            }
#pragma unroll 1
            for (int q = 0; q < 8; ++q) {
                c2 Z[8], Y[8];
#pragma unroll
                for (int j = 0; j < 8; ++j) { Z[j] = sZ[(j * 8 + q) * 512 + tid]; Y[j] = (c2){0.f, 0.f}; }
#pragma unroll
                for (int d = -7; d <= 7; ++d) { const c2 kd = sK[((d + 7) * 8 + q) * 512 + tid];
#pragma unroll
                    for (int i = 0; i < 8; ++i) if (i - d >= 0 && i - d < 8) Y[i] += cmul(Z[i - d], kd); }
#pragma unroll
                for (int a = 0; a < 4; ++a) sZ[(a * 8 + q) * 512 + tid] = (c2){Y[2 * a].x - Y[2 * a + 1].y, Y[2 * a].y + Y[2 * a + 1].x};
            }
            {
                QuadRegs R = quad_load(zrow, grow, gs, true, true, false, tid);
#pragma unroll 1
                for (int a = 0; a < 2; ++a) {
                    const int gq = gs + a * 8192;
                    __syncthreads();
                    quad_store(R, raw, tid);
                    __syncthreads();
                    if (a < 1) R = quad_load(zrow, grow, gs + 8192, true, false, true, tid);
                    c2 x0[8], x1[8];
#pragma unroll
                    for (int q = 0; q < 8; ++q) { x0[q] = sZ[((2 * a) * 8 + q) * 512 + tid]; x1[q] = sZ[((2 * a + 1) * 8 + q) * 512 + tid]; }
                    fft_inv_regs2(x0, x1, buf0, buf1, tws, tid);
                    EPI(x0, 0, gq); EPI(x1, 2, gq);
                }
            }
        }
#undef ZVAL
#undef EPI
#undef EPIZ
        __syncthreads();
    }
}

typedef short v4i16_t __attribute__((ext_vector_type(4)));
__device__ __forceinline__ v4i16_t lds_tr16(const bf16_t* p) { return __builtin_amdgcn_ds_read_tr16_b64_v4i16((LAS v4i16_t*)p); }
constexpr int ATT_LD = 72;
constexpr int ATT_BYTES = (128 + 256 + 256) * ATT_LD * 2;
__device__ void phase_attn(const Params& p, unsigned char* smem, int wave) {
    const int tid = fresh_tid(wave), ht = tid, w4 = tid >> 6, lane = tid & 63, ql = lane & 15, gq = lane >> 4;
    bf16_t* Qs = (bf16_t*)smem; bf16_t* Ks = Qs + 128 * ATT_LD; bf16_t* Vs = Ks + 256 * ATT_LD;
    const bf16_t* qkv = (const bf16_t*)(p.ws + WS_RC);
    float* lse = (float*)(p.ws + WS_LSE);
    const int npairs = 15360;
    u32x4 qr[2], kr[4], vr[4];
#define ATT_DECODE(pr_) \
        const int it = (pr_); \
        const int tile = it % 640, hb = it / 640, h = hb & 7, br = hb >> 3; \
        const int d = br == 0 ? 1 : (br == 1 ? 4 : 16); \
        int gbase, T, lb; \
        if (tile < 512) { gbase = (tile >> 4) * TP; T = TP; lb = tile & 15; } else { gbase = NPTOK; T = TS; lb = tile - 512; } \
        const int Ls = T / d, res = lb % d, i0 = (lb / d) * 128;
#define ATT_LOAD() do { const int ht_ = fresh_tid(wave); \
        _Pragma("unroll") for (int c_ = 0; c_ < 2; ++c_) { const int e = ht_ + 512 * c_; const int r = e >> 3, ch = e & 7; const int tok = gbase + (i0 + r) * d + res; \
            qr[c_] = *(const u32x4*)(qkv + (unsigned)(tok * 1536 + h * 64 + ch * 8)); } \
        _Pragma("unroll") for (int c_ = 0; c_ < 4; ++c_) { const int e = ht_ + 512 * c_; const int r = e >> 3, ch = e & 7; const int j = i0 - 64 + r; \
            kr[c_] = (u32x4){0u, 0u, 0u, 0u}; vr[c_] = kr[c_]; \
            if (j >= 0 && j < Ls) { const unsigned off = (unsigned)((gbase + j * d + res) * 1536 + h * 64 + ch * 8); kr[c_] = *(const u32x4*)(qkv + off + 512); vr[c_] = *(const u32x4*)(qkv + off + 1024); } } } while (0)
    if ((int)blockIdx.x < npairs) { ATT_DECODE(blockIdx.x) ATT_LOAD(); }
    for (int pr = blockIdx.x; pr < npairs; pr += gridDim.x) {
        ATT_DECODE(pr)
        bf16_t* ato = (bf16_t*)(p.ws + (br < 2 ? WS_RA + br * ATO_STRIDE_01 : WS_ATO2));
        __syncthreads();
        const int hs = fresh_tid(wave);
#pragma unroll
        for (int c_ = 0; c_ < 2; ++c_) { const int e = hs + 512 * c_; *(u32x4*)(Qs + (e >> 3) * ATT_LD + (e & 7) * 8) = qr[c_]; }
#pragma unroll
        for (int c_ = 0; c_ < 4; ++c_) { const int e = hs + 512 * c_; *(u32x4*)(Ks + (e >> 3) * ATT_LD + (e & 7) * 8) = kr[c_]; *(u32x4*)(Vs + (e >> 3) * ATT_LD + (e & 7) * 8) = vr[c_]; }
        __syncthreads();
        if (pr + (int)gridDim.x < npairs) { ATT_DECODE(pr + gridDim.x) ATT_LOAD(); }
        const bf16x8 qf0 = *(const bf16x8*)(Qs + (16 * w4 + ql) * ATT_LD + gq * 8), qf1 = *(const bf16x8*)(Qs + (16 * w4 + ql) * ATT_LD + 32 + gq * 8);
        f32x4 sc[10];
#pragma unroll
        for (int kt = 0; kt < 9; ++kt) { const bf16_t* kr = Ks + (16 * w4 + 16 * kt + ql) * ATT_LD + gq * 8;
            f32x4 a = (f32x4){0.f, 0.f, 0.f, 0.f};
            a = __builtin_amdgcn_mfma_f32_16x16x32_bf16(*(const bf16x8*)kr, qf0, a, 0, 0, 0);
            a = __builtin_amdgcn_mfma_f32_16x16x32_bf16(*(const bf16x8*)(kr + 32), qf1, a, 0, 0, 0);
            sc[kt] = a; if (kt % 3 == 2) __builtin_amdgcn_sched_barrier(0); }
        const float slope = exp2f(-(float)(h + 1)) * (float)d * 1.4426950408889634f;
        const int qi = i0 + 16 * w4 + ql;
        float mx = -1e30f;
#pragma unroll
        for (int kt = 0; kt < 9; ++kt)
#pragma unroll
            for (int j = 0; j < 4; ++j) { const int rel = 16 * kt + 4 * gq + j - 64 - ql; const int jk = qi + rel;
                const bool relok = (kt == 0) ? (rel >= -64) : ((kt == 8) ? (rel <= 64) : true);
                const bool ok = relok && ((unsigned)jk < (unsigned)Ls);
                const float v = ok ? sc[kt][j] * 0.18033688011112042f - slope * fabsf((float)rel) : -1e30f;
                sc[kt][j] = v; mx = fmaxf(mx, v); }
        mx = fmaxf(mx, __shfl_xor(mx, 16)); mx = fmaxf(mx, __shfl_xor(mx, 32));
        float den = 0.f;
#pragma unroll
        for (int kt = 0; kt < 9; ++kt)
#pragma unroll
            for (int j = 0; j < 4; ++j) { const float pv = __builtin_amdgcn_exp2f(sc[kt][j] - mx); sc[kt][j] = pv; den += pv; }
        sc[9] = (f32x4){0.f, 0.f, 0.f, 0.f};
        den += __shfl_xor(den, 16); den += __shfl_xor(den, 32);
        f32x4 oacc[4];
#pragma unroll
        for (int et = 0; et < 4; ++et) oacc[et] = (f32x4){0.f, 0.f, 0.f, 0.f};
#pragma unroll
        for (int ks = 0; ks < 5; ++ks) {
            u32x4 pu; pu.x = cvtpk(sc[2 * ks][0], sc[2 * ks][1]); pu.y = cvtpk(sc[2 * ks][2], sc[2 * ks][3]); pu.z = cvtpk(sc[2 * ks + 1][0], sc[2 * ks + 1][1]); pu.w = cvtpk(sc[2 * ks + 1][2], sc[2 * ks + 1][3]);
            const bf16x8 pf = __builtin_bit_cast(bf16x8, pu);
            const bf16_t* vrow = Vs + (16 * w4 + 32 * ks + 4 * gq + (ql >> 2)) * ATT_LD + 4 * (ql & 3);
#pragma unroll
            for (int et = 0; et < 4; ++et) {
                const v4i16_t t0 = lds_tr16(vrow + 16 * et);
                v4i16_t t1 = (v4i16_t){0, 0, 0, 0};
                if (ks < 4) t1 = lds_tr16(vrow + 16 * ATT_LD + 16 * et);
                const bf16x8 vf = __builtin_shufflevector(t0, t1, 0, 1, 2, 3, 4, 5, 6, 7);
                oacc[et] = __builtin_amdgcn_mfma_f32_16x16x32_bf16(pf, vf, oacc[et], 0, 0, 0); }
            __builtin_amdgcn_sched_barrier(0);
        }
#pragma unroll
        for (int j = 0; j < 4; ++j) { const float dq = __shfl(den, 4 * gq + j); const float inv = __builtin_amdgcn_rcpf(dq);
            const int tok = gbase + (i0 + 16 * w4 + 4 * gq + j) * d + res;
#pragma unroll
            for (int et = 0; et < 4; ++et) ato[(size_t)tok * 512 + h * 64 + 16 * et + ql] = f2bf(oacc[et][j] * inv); }
        if (gq == 0) { const int tok = gbase + qi * d + res; lse[((size_t)br * NTOK + tok) * 8 + h] = mx * 0.6931471805599453f + __logf(den); }
    }
}

__device__ void phase_mixin(const Params& p, unsigned char* smem, int wave) {
    const int tid = fresh_tid(wave);
    bf16_t* tl = (bf16_t*)smem;
    const bf16_t* hy = (const bf16_t*)(p.ws + WS_RE);
    const float* lse = (const float*)(p.ws + WS_LSE);
    bf16_t* mix = (bf16_t*)(p.ws + WS_RC);
    for (int it = blockIdx.x; it < NTOK / 64; it += gridDim.x) {
        const int g0 = it * 64;
        const int tt = tid >> 3, sub = tid & 7, g = g0 + tt;
        u32x4 tv[8], av[8], bv[8], cv[8];
        { const bf16_t* src = hy + (size_t)tid * NTOK + g0;
#pragma unroll
          for (int q = 0; q < 8; ++q) tv[q] = *(const u32x4*)(src + 8 * q); }
        const int h = sub;
        const float l0 = lse[((size_t)0 * NTOK + g) * 8 + h], l1 = lse[((size_t)1 * NTOK + g) * 8 + h], l2 = lse[((size_t)2 * NTOK + g) * 8 + h];
        { const bf16_t* o0 = (const bf16_t*)(p.ws + WS_RA) + (size_t)g * 512 + h * 64;
          const bf16_t* o1 = (const bf16_t*)(p.ws + WS_RA + ATO_STRIDE_01) + (size_t)g * 512 + h * 64;
          const bf16_t* o2 = (const bf16_t*)(p.ws + WS_ATO2) + (size_t)g * 512 + h * 64;
#pragma unroll
          for (int q = 0; q < 8; ++q) { av[q] = *(const u32x4*)(o0 + 8 * q); bv[q] = *(const u32x4*)(o1 + 8 * q); cv[q] = *(const u32x4*)(o2 + 8 * q); } }
        __syncthreads();
#pragma unroll
        for (int q = 0; q < 8; ++q) { unsigned* dst = (unsigned*)(tl + tid * 66 + 8 * q); dst[0] = tv[q].x; dst[1] = tv[q].y; dst[2] = tv[q].z; dst[3] = tv[q].w; }
        __syncthreads();
        { float ss = 0.f;
          for (int c = sub * 64; c < sub * 64 + 64; ++c) { const float v = bf2f(tl[c * 66 + tt]); ss += v * v; }
          ss += __shfl_xor(ss, 1); ss += __shfl_xor(ss, 2); ss += __shfl_xor(ss, 4);
          const float r = rsqrtf(ss * (1.f / 512.f) + EPS);
          bf16_t* dst = mix + (size_t)g * D + sub * 64;
#pragma unroll
          for (int q = 0; q < 8; ++q) { float v[8];
              const f32x4 ga = *(const f32x4*)(p.hy_out_g + sub * 64 + 8 * q), gb4 = *(const f32x4*)(p.hy_out_g + sub * 64 + 8 * q + 4);
#pragma unroll
              for (int j = 0; j < 8; ++j) { const int c = sub * 64 + 8 * q + j; v[j] = bf2f(tl[c * 66 + tt]) * r * (j < 4 ? ga[j & 3] : gb4[j & 3]); }
              u32x4 w; w.x = pk2(v[0], v[1]); w.y = pk2(v[2], v[3]); w.z = pk2(v[4], v[5]); w.w = pk2(v[6], v[7]);
              *(u32x4*)(dst + 8 * q) = w; } }
        { const float lm = fmaxf(l0, fmaxf(l1, l2)); float w0 = __expf(l0 - lm), w1 = __expf(l1 - lm), w2 = __expf(l2 - lm); const float wi = 1.f / (w0 + w1 + w2); w0 *= wi; w1 *= wi; w2 *= wi;
          float ss = 0.f;
#pragma unroll
          for (int q = 0; q < 8; ++q) { const u32x4 a = av[q], b = bv[q], c = cv[q];
#pragma unroll
              for (int j = 0; j < 4; ++j) { const float lo = w0 * bf2f((bf16_t)a[j]) + w1 * bf2f((bf16_t)b[j]) + w2 * bf2f((bf16_t)c[j]);
                  const float hi = w0 * bf2f((bf16_t)(a[j] >> 16)) + w1 * bf2f((bf16_t)(b[j] >> 16)) + w2 * bf2f((bf16_t)(c[j] >> 16)); ss += lo * lo + hi * hi; } }
          ss += __shfl_xor(ss, 1); ss += __shfl_xor(ss, 2); ss += __shfl_xor(ss, 4);
          const float r = rsqrtf(ss * (1.f / 512.f) + EPS);
          bf16_t* dst = mix + (size_t)g * D + 512 + h * 64; const float* ag = p.attn_out_g + h * 64;
#pragma unroll
          for (int q = 0; q < 8; ++q) { const u32x4 a = av[q], b = bv[q], c = cv[q]; u32x4 w;
#pragma unroll
              for (int j = 0; j < 4; ++j) { const float lo = w0 * bf2f((bf16_t)a[j]) + w1 * bf2f((bf16_t)b[j]) + w2 * bf2f((bf16_t)c[j]);
                  const float hi = w0 * bf2f((bf16_t)(a[j] >> 16)) + w1 * bf2f((bf16_t)(b[j] >> 16)) + w2 * bf2f((bf16_t)(c[j] >> 16));
                  w[j] = pk2(lo * r * ag[8 * q + 2 * j], hi * r * ag[8 * q + 2 * j + 1]); }
              *(u32x4*)(dst + 8 * q) = w; } }
    }
}

__device__ __forceinline__ void grid_bar(unsigned* ctr, unsigned target, int wave) {
    __builtin_amdgcn_s_waitcnt(0x0F70);
    __syncthreads();
    if (wave == 0) {
        int l; asm volatile("v_mbcnt_lo_u32_b32 %0, -1, 0\n\tv_mbcnt_hi_u32_b32 %0, -1, %0" : "=v"(l));
        if (l == 0) {
            __builtin_amdgcn_fence(__ATOMIC_RELEASE, "agent");
            __hip_atomic_fetch_add(ctr, 1u, __ATOMIC_RELAXED, __HIP_MEMORY_SCOPE_AGENT);
            while (__hip_atomic_load(ctr, __ATOMIC_RELAXED, __HIP_MEMORY_SCOPE_AGENT) < target) __builtin_amdgcn_s_sleep(2);
            __builtin_amdgcn_fence(__ATOMIC_ACQUIRE, "agent");
        }
    }
    __syncthreads();
}
constexpr int NPH = 13;
__global__ void __launch_bounds__(NTHR, 2) fwd_kernel(Params p) {
    extern __shared__ __attribute__((aligned(16))) unsigned char smem[];
    cg::grid_group grid = cg::this_grid();
    const int lo = p.ph_lo, hi = p.ph_hi;
    const int wave = __builtin_amdgcn_readfirstlane(threadIdx.x >> 6);
    unsigned* barctr = (unsigned*)(p.ws + WS_BAR);
    if (hi - lo > 1) grid.sync();
    unsigned char* ws = p.ws;
    const float* mod = (const float*)(ws + WS_MOD);
    bf16_t* hbuf = (bf16_t*)(ws + WS_RA);
#ifndef REP_MASK
#define REP_MASK 0
#endif
#define PH(k) if (lo <= (k) && (k) < hi) for (int rep_ = 0; rep_ <= ((REP_MASK >> (k)) & 1); ++rep_)
#define SEAM(k) if (lo <= (k) && (k) + 1 < hi) grid_bar(barctr, (unsigned)((k) + 1 - lo) * gridDim.x, wave)
    PH(0) { phase_prep(p, (float*)smem, wave); } SEAM(0);
    PH(1) { phase_hrows(p, p.x_prompt, p.x_sample, p.norm1_g, 0, 1024, hbuf, wave); } SEAM(1);
    PH(2) { pg8::Gemm g{hbuf, (const bf16_t*)(ws + WS_WIN), NTOK, NPROJ, D}; pg8::StaticOrder S; S.init(NTOK, NPROJ, gridDim.x, blockIdx.x);
            EpiProj E{(bf16_t*)(ws + WS_RB), (bf16_t*)(ws + WS_RC)}; pg8::gemm_phase<EpiProj>((LAS unsigned char*)smem, g, S, E, wave); } SEAM(2);
    for (int o = 0; o < 2; ++o) { PH(3 + o) { phase_conv(p, o, smem, wave); } SEAM(3 + o); }
    PH(5) { phase_attn(p, smem, wave); } SEAM(5);
    PH(6) { phase_mixin(p, smem, wave); } SEAM(6);
    PH(7) { pg8::Gemm g{(const bf16_t*)(ws + WS_RC), (const bf16_t*)(ws + WS_WOUT), NTOK, D, D}; pg8::StaticOrder S; S.init(NTOK, D, gridDim.x, blockIdx.x);
            EpiRes E{p.x_prompt, p.x_sample, p.out, mod + 2048}; pg8::gemm_phase<EpiRes>((LAS unsigned char*)smem, g, S, E, wave); } SEAM(7);
    PH(8) { phase_hrows(p, p.out, p.out + (size_t)NPTOK * D, p.norm2_g, 3072, 4096, hbuf, wave); } SEAM(8);
    PH(9) { pg8::Gemm g{hbuf, (const bf16_t*)(ws + WS_WGU), NTOK, 2 * DFF, D}; pg8::StaticOrder S; S.init(NTOK, 2 * DFF, gridDim.x, blockIdx.x);
            EpiGUF E{(bf16_t*)(ws + WS_RB), (float*)(ws + WS_SBP), (float*)(ws + WS_SBU), (float*)(ws + WS_SBG), p.ffn_conv_w, p.ffn_conv_b, (float*)(smem + 131072)}; pg8::gemm_phase<EpiGUF>((LAS unsigned char*)smem, g, S, E, wave); } SEAM(9);
    PH(10) { phase_fix(p, (bf16_t*)(ws + WS_RB), wave); } SEAM(10);
    PH(11) { pg8::Gemm g{(const bf16_t*)(ws + WS_RB), (const bf16_t*)(ws + WS_WD), NTOK, D, DFF}; pg8::StaticOrder S; S.init(NTOK, D, gridDim.x, blockIdx.x);
            EpiRes E{p.out, p.out + (size_t)NPTOK * D, p.out, mod + 5120}; pg8::gemm_phase<EpiRes>((LAS unsigned char*)smem, g, S, E, wave); } SEAM(11);
    PH(12) { phase_final(p, wave); }
#undef PH
#undef SEAM
}

extern "C" void kernel_launch(void* const* d_in, const int* in_sizes, int n_in, void* d_out, int out_size, void* d_ws, size_t ws_size, hipStream_t stream) {
    static int grid = 0;
    if (grid == 0) {
        if (n_in != 28 || ws_size < WS_END) { fprintf(stderr, "kernel_launch: need 28 inputs and %zu bytes of workspace (got %d, %zu)\n", (size_t)WS_END, n_in, ws_size); grid = -1; return; }
        int dev = 0, cus = 0;
        (void)hipGetDevice(&dev); (void)hipDeviceGetAttribute(&cus, hipDeviceAttributeMultiprocessorCount, dev);
        if (hipFuncSetAttribute((const void*)fwd_kernel, hipFuncAttributeMaxDynamicSharedMemorySize, LDS_BYTES) != hipSuccess) { fprintf(stderr, "hipFuncSetAttribute failed\n"); grid = -1; return; }
        int per_cu = 0;
        if (hipOccupancyMaxActiveBlocksPerMultiprocessor(&per_cu, (const void*)fwd_kernel, NTHR, LDS_BYTES) != hipSuccess || per_cu < 1) { fprintf(stderr, "occupancy query: %d\n", per_cu); (void)hipGetLastError(); }
        grid = cus > 0 ? cus : 256;
    }
    if (grid < 0) return;
    (void)hipMemsetAsync((char*)d_ws + WS_NORM, 0, 16384 + 256, stream);
    Params p{};
    const float** pp = (const float**)&p;
    for (int i = 0; i < 28; ++i) pp[i] = (const float*)d_in[i];
    p.out = (float*)d_out; p.ws = (unsigned char*)d_ws; p.ph_lo = 0; p.ph_hi = NPH;
#if defined(MULTI_LAUNCH)
    for (int k = 0; k < NPH; ++k) { p.ph_lo = k; p.ph_hi = k + 1; hipLaunchKernelGGL(fwd_kernel, dim3(grid), dim3(NTHR), LDS_BYTES, stream, p); }
#else
    void* args[] = {&p};
    hipError_t e = hipLaunchCooperativeKernel((const void*)fwd_kernel, dim3(grid), dim3(NTHR), args, LDS_BYTES, stream);
    if (e != hipSuccess) fprintf(stderr, "cooperative launch failed: %s (grid %d)\n", hipGetErrorString(e), grid);
#endif
}
```
